# Optimizing an MI355X kernel written in HIP

```python
import math
import jax, jax.numpy as jnp
from jax import lax
import numpy as np

D_MODEL = 2048
BATCH = 16
SEQ = 256
DEPTH = 2
DEC_BATCH = 4
DEC_SEQ = 1024
PAST_LEN = 512

GRID_W = 64
N_MIXERS = 2
N_HYENA = (DEPTH + 1) // 2
N_RET = DEPTH // 2
D_FF = 4 * D_MODEL
EPS = 1e-6
HYENA_ORDER = 2
FILTER_BANDS = 16
FILTER_EMB = 1 + 2 * FILTER_BANDS
FILTER_WIDTH = 64
DECAY_FAST_PCT = 0.3
DECAY_SLOW_PCT = 1.5
DECAY_TARGET = 1e-2
MIN_DECAY = math.log(DECAY_TARGET) / DECAY_SLOW_PCT
MAX_DECAY = math.log(DECAY_TARGET) / DECAY_FAST_PCT
RET_HEADS = 8
RET_DK = D_MODEL // RET_HEADS
RET_DV = 2 * D_MODEL // RET_HEADS
RET_CHUNK = 128
ROPE_BASE = 10000.0

kernel_name = "hyena_retnet_prefix_dit_step"


def _rms_norm(x, g):
    xf = x.astype(jnp.float32)
    y = xf * lax.rsqrt(jnp.mean(xf * xf, axis=-1, keepdims=True) + EPS)
    return (y * g.astype(jnp.float32)).astype(x.dtype)


def _short_conv(x, w, b):
    xp = jnp.pad(x, ((0, 0), (1, 1), (0, 0)))
    return xp[:, :-2] * w[0] + xp[:, 1:-1] * w[1] + xp[:, 2:] * w[2] + b


def _hyena_filters(L, w1, b1, w2, b2, w3, b3, freq, w_out):
    f32 = jnp.float32
    pos = jnp.arange(L, dtype=f32)
    t = pos / L
    omega = 2.0 * math.pi * pos / L
    bands = jnp.linspace(1e-4, FILTER_BANDS - 1, FILTER_BANDS, dtype=f32)
    ang = omega[:, None] * bands[None, :]
    feat = jnp.concatenate([t[:, None], jnp.cos(ang), -jnp.sin(ang)], axis=-1)
    freq = freq.astype(f32)
    h = jnp.sin(freq[0] * (feat @ w1.astype(f32) + b1.astype(f32)))
    h = jnp.sin(freq[1] * (h @ w2.astype(f32) + b2.astype(f32)))
    h = jnp.sin(freq[2] * (h @ w3.astype(f32) + b3.astype(f32)))
    h = h @ w_out.astype(f32)
    deltas = jnp.abs(jnp.linspace(MIN_DECAY, MAX_DECAY, D_MODEL, dtype=f32))
    window = jnp.exp(-t[:, None] * deltas[None, :])
    return h.reshape(L, HYENA_ORDER, 2, D_MODEL) * window[:, None, None, :]


def _long_conv(u, hf, hb, skip):
    L = u.shape[1]
    n = 2 * L
    k = jnp.concatenate([hf, jnp.zeros((1, hf.shape[1]), hf.dtype), hb[:0:-1]], axis=0)
    y = jnp.fft.irfft(jnp.fft.rfft(u, n=n, axis=1) * jnp.fft.rfft(k, n=n, axis=0)[None], n=n, axis=1)[:, :L]
    return y + u * skip.astype(jnp.float32)


def _hyena(h, w_in, b_in, conv_w, conv_b, f_w1, f_b1, f_w2, f_b2, f_w3, f_b3, f_freq, f_wout, f_skip, w_out, b_out):
    L = h.shape[1]
    proj = _short_conv(h @ w_in + b_in, conv_w, conv_b).astype(jnp.float32)
    v, x1, x2 = jnp.split(proj, 3, axis=-1)
    filt = _hyena_filters(L, f_w1, f_b1, f_w2, f_b2, f_w3, f_b3, f_freq, f_wout)
    z = x1 * _long_conv(v, filt[:, 0, 0], filt[:, 0, 1], f_skip[0])
    z = x2 * _long_conv(z, filt[:, 1, 0], filt[:, 1, 1], f_skip[1])
    return z.astype(h.dtype) @ w_out + b_out


def _axial_rotary(x):
    f32 = jnp.float32
    L = x.shape[1]
    n_rows = L // GRID_W
    rows = jnp.repeat(jnp.arange(n_rows, dtype=f32), GRID_W)
    cols = jnp.tile(jnp.arange(GRID_W, dtype=f32), n_rows)
    n_pairs = RET_DK // 4
    inv = ROPE_BASE ** (-jnp.arange(n_pairs, dtype=f32) / n_pairs)
    ang = jnp.concatenate([rows[:, None] * inv, cols[:, None] * inv], axis=-1)
    cos = jnp.cos(ang)[None, :, None, :]
    sin = jnp.sin(ang)[None, :, None, :]
    xp = x.reshape(*x.shape[:-1], RET_DK // 2, 2)
    x0, x1 = xp[..., 0], xp[..., 1]
    return jnp.stack([x0 * cos - x1 * sin, x0 * sin + x1 * cos], axis=-1).reshape(x.shape)


def _retention_scan(q, k, v, log_g, s0):
    B, H, L, _ = q.shape
    C = RET_CHUNK
    n = L // C
    idx = jnp.arange(C, dtype=jnp.float32)
    diff = idx[:, None] - idx[None, :]
    lower = diff >= 0
    intra = jnp.where(lower, jnp.exp(jnp.where(lower, diff, 0.0)[None] * log_g[:, None, None]), 0.0)
    q_decay = jnp.exp((idx[None, :] + 1.0) * log_g[:, None])[..., None]
    k_decay = jnp.exp((C - 1.0 - idx[None, :]) * log_g[:, None])[..., None]
    chunk_decay = jnp.exp(C * log_g)[:, None, None]
    qs = jnp.moveaxis(q.reshape(B, H, n, C, RET_DK), 2, 0)
    ks = jnp.moveaxis(k.reshape(B, H, n, C, RET_DK), 2, 0)
    vs = jnp.moveaxis(v.reshape(B, H, n, C, RET_DV), 2, 0)

    def body(s, qkv):
        qc, kc, vc = qkv
        scores = jnp.einsum('bhid,bhjd->bhij', qc, kc) * intra
        out = jnp.einsum('bhij,bhjv->bhiv', scores, vc) + jnp.einsum('bhid,bhdv->bhiv', qc * q_decay, s)
        s_new = s * chunk_decay + jnp.einsum('bhjd,bhjv->bhdv', kc * k_decay, vc)
        return s_new, out

    s_final, outs = lax.scan(body, s0, (qs, ks, vs))
    return jnp.moveaxis(outs, 0, 2).reshape(B, H, L, RET_DV), s_final


def _retention(h, s0, w_qkvg, decay_logit, gn_g, w_o, grid_positions):
    f32 = jnp.float32
    B, L, _ = h.shape
    q, k, v, g = jnp.split(h @ w_qkvg, [D_MODEL, 2 * D_MODEL, 4 * D_MODEL], axis=-1)
    q = q.reshape(B, L, RET_HEADS, RET_DK).astype(f32)
    k = k.reshape(B, L, RET_HEADS, RET_DK).astype(f32)
    if grid_positions:
        q = _axial_rotary(q)
        k = _axial_rotary(k)
    k = k * RET_DK ** -0.5
    v = v.reshape(B, L, RET_HEADS, RET_DV).astype(f32)
    q, k, v = (jnp.swapaxes(a, 1, 2) for a in (q, k, v))
    log_g = jax.nn.log_sigmoid(decay_logit.astype(f32))
    s0 = s0.astype(f32)
    y_f, s_f = _retention_scan(q, k, v, log_g[0], s0[:, 0])
    y_b, s_b = _retention_scan(jnp.flip(q, 2), jnp.flip(k, 2), jnp.flip(v, 2), log_g[1], s0[:, 1])
    y = jnp.swapaxes(y_f + jnp.flip(y_b, 2), 1, 2)
    mu = jnp.mean(y, axis=-1, keepdims=True)
    var = jnp.mean(jnp.square(y - mu), axis=-1, keepdims=True)
    y = ((y - mu) * lax.rsqrt(var + EPS)).reshape(B, L, 2 * D_MODEL) * gn_g.astype(f32)
    out = (jax.nn.silu(g.astype(f32)) * y).astype(h.dtype) @ w_o
    return out, jnp.stack([s_f, s_b], axis=1)


def _sq_relu_mlp(h, w1, w2):
    return jnp.square(jax.nn.relu(h @ w1)) @ w2


def setup_inputs(seed: int = 0) -> dict:
    key = jax.random.key(seed)
    ks = jax.random.split(key, 32)
    f32 = jnp.float32
    D = D_MODEL

    def nrm(k, shape, s):
        return jax.random.normal(k, shape, f32) * s

    base_logit = jnp.log(2.0 ** (5.0 + jnp.arange(RET_HEADS, dtype=f32)) - 1.0)
    return {
        "x_prompt": nrm(ks[0], (BATCH, SEQ, D), 1.0),
        "x_sample": nrm(ks[1], (DEC_BATCH, DEC_SEQ, D), 1.0),
        "state_ret": nrm(ks[2], (DEC_BATCH, N_RET, 2, RET_HEADS, RET_DK, RET_DV), 0.1),
        "c": nrm(ks[3], (DEC_BATCH, D), 1.0),
        "c_ctx": nrm(ks[4], (D,), 1.0),
        "w_ada": nrm(ks[5], (DEPTH, D, 6 * D), 0.5 * D ** -0.5),
        "b_ada": nrm(ks[6], (DEPTH, 6 * D), 0.02),
        "norm_g": 1.0 + nrm(ks[7], (DEPTH, 2, D), 0.02),
        "final_g": 1.0 + nrm(ks[8], (D,), 0.02),
        "hy_w_in": nrm(ks[9], (N_HYENA, D, 3 * D), D ** -0.5),
        "hy_b_in": nrm(ks[10], (N_HYENA, 3 * D), 0.02),
        "hy_conv_w": nrm(ks[11], (N_HYENA, 3, 3 * D), 0.5),
        "hy_conv_b": nrm(ks[12], (N_HYENA, 3 * D), 0.02),
        "hy_f_w1": nrm(ks[13], (N_HYENA, FILTER_EMB, FILTER_WIDTH), FILTER_EMB ** -0.5),
        "hy_f_b1": nrm(ks[14], (N_HYENA, FILTER_WIDTH), 0.1),
        "hy_f_w2": nrm(ks[15], (N_HYENA, FILTER_WIDTH, FILTER_WIDTH), FILTER_WIDTH ** -0.5),
        "hy_f_b2": nrm(ks[16], (N_HYENA, FILTER_WIDTH), 0.1),
        "hy_f_w3": nrm(ks[17], (N_HYENA, FILTER_WIDTH, FILTER_WIDTH), FILTER_WIDTH ** -0.5),
        "hy_f_b3": nrm(ks[18], (N_HYENA, FILTER_WIDTH), 0.1),
        "hy_f_freq": 1.0 + nrm(ks[19], (N_HYENA, 3, FILTER_WIDTH), 0.01),
        "hy_f_wout": nrm(ks[20], (N_HYENA, FILTER_WIDTH, HYENA_ORDER * 2 * D), 0.1 * FILTER_WIDTH ** -0.5),
        "hy_f_skip": nrm(ks[21], (N_HYENA, HYENA_ORDER, D), 0.5),
        "hy_w_out": nrm(ks[22], (N_HYENA, D, D), D ** -0.5),
        "hy_b_out": nrm(ks[23], (N_HYENA, D), 0.02),
        "ret_w_qkvg": nrm(ks[24], (N_RET, D, 6 * D), D ** -0.5),
        "ret_decay": base_logit[None, None, :] + nrm(ks[25], (N_RET, 2, RET_HEADS), 0.1),
        "ret_gn_g": 1.0 + nrm(ks[26], (N_RET, 2 * D), 0.02),
        "ret_w_o": nrm(ks[27], (N_RET, 2 * D, D), (2 * D) ** -0.5),
        "mlp_w1": nrm(ks[28], (DEPTH, D, D_FF), D ** -0.5),
        "mlp_w2": nrm(ks[29], (DEPTH, D_FF, D), D_FF ** -0.5),
    }


def reference(x_prompt, x_sample, state_ret, c, c_ctx, w_ada, b_ada, norm_g, final_g,
              hy_w_in, hy_b_in, hy_conv_w, hy_conv_b, hy_f_w1, hy_f_b1, hy_f_w2, hy_f_b2,
              hy_f_w3, hy_f_b3, hy_f_freq, hy_f_wout, hy_f_skip, hy_w_out, hy_b_out,
              ret_w_qkvg, ret_decay, ret_gn_g, ret_w_o, mlp_w1, mlp_w2):

    def run(x, cond, s_init, latent):
        cond_act = jax.nn.silu(cond)
        states = []
        for layer in range(DEPTH):
            mod = (cond_act @ w_ada[layer] + b_ada[layer])[:, None, :]
            sh1, sc1, g1, sh2, sc2, g2 = jnp.split(mod, 6, axis=-1)
            h = _rms_norm(x, norm_g[layer, 0]) * (1.0 + sc1) + sh1
            i = layer // N_MIXERS
            if layer % N_MIXERS == 0:
                m = _hyena(h, hy_w_in[i], hy_b_in[i], hy_conv_w[i], hy_conv_b[i],
                           hy_f_w1[i], hy_f_b1[i], hy_f_w2[i], hy_f_b2[i], hy_f_w3[i], hy_f_b3[i],
                           hy_f_freq[i], hy_f_wout[i], hy_f_skip[i], hy_w_out[i], hy_b_out[i])
            else:
                m, s = _retention(h, s_init[:, i], ret_w_qkvg[i], ret_decay[i], ret_gn_g[i], ret_w_o[i], latent)
                states.append(s)
            x = x + g1 * m
            h = _rms_norm(x, norm_g[layer, 1]) * (1.0 + sc2) + sh2
            x = x + g2 * _sq_relu_mlp(h, mlp_w1[layer], mlp_w2[layer])
        return _rms_norm(x, final_g), states

    zero_state = jnp.zeros((x_prompt.shape[0], N_RET, 2, RET_HEADS, RET_DK, RET_DV), jnp.float32)
    y_prompt, ctx_states = run(x_prompt, c_ctx[None, :], zero_state, False)
    y_sample, _ = run(x_sample, c, state_ret, True)
    new_state_ret = jnp.stack(ctx_states, axis=1).astype(x_prompt.dtype)
    return (y_prompt, y_sample, new_state_ret)
```

```cpp
#include <hip/hip_runtime.h>
#include <hip/hip_cooperative_groups.h>
#include <cstdio>
#include <cstdint>
namespace cg = cooperative_groups;

#define LAS __attribute__((address_space(3)))
#define DI __device__ __forceinline__
typedef unsigned short bf16_t;
typedef short bf16x8 __attribute__((ext_vector_type(8)));
typedef float f32x4 __attribute__((ext_vector_type(4)));
typedef float f32x16 __attribute__((ext_vector_type(16)));
typedef unsigned u32x4 __attribute__((ext_vector_type(4)));
typedef unsigned u32x2 __attribute__((ext_vector_type(2)));

constexpr int D = 2048, NTOK = 8192, NPT = 4096, FF = 8192;
constexpr float EPS = 1e-6f;
constexpr int NWAVES = 8;
constexpr int LDS_BYTES = 147456;
#ifndef DUPMASK
#define DUPMASK 0
#endif
#ifndef EXTRASYNC
#define EXTRASYNC 0
#endif

constexpr size_t MiB = 1u << 20;
constexpr size_t OFF_MOD = 0, MOD_BYTES = 2 * 5 * 12288 * 4;
constexpr size_t OFF_BAR = 512 * 1024, OFF_PCNT = OFF_BAR + 16384, CTL_ZERO_BYTES = OFF_PCNT + 3 * 32 * 256;
constexpr size_t OFF_H3 = 1 * MiB;
constexpr size_t OFF_WIN = 2 * MiB, OFF_WHYO = 26 * MiB, OFF_WQKVG = 34 * MiB, OFF_WO = 82 * MiB, OFF_W1 = 98 * MiB, OFF_W2 = 162 * MiB;
constexpr size_t OFF_RGS = 226 * MiB, OFF_RGP = 242 * MiB, OFF_S0T = 246 * MiB, OFF_H = 262 * MiB, OFF_BIG = 294 * MiB;
constexpr size_t OFF_PROJT = OFF_BIG, OFF_Z2T = OFF_BIG + 96 * MiB, OFF_Z2 = OFF_BIG + 128 * MiB;
constexpr size_t OFF_U = OFF_BIG;
constexpr size_t OFF_QK = OFF_BIG, OFF_G = OFF_BIG + 64 * MiB, OFF_VT = OFF_BIG + 128 * MiB, OFF_KTF = OFF_BIG + 192 * MiB, OFF_KTB = OFF_BIG + 208 * MiB,
                 OFF_QFB = OFF_BIG + 224 * MiB, OFF_PS = OFF_BIG + 256 * MiB, OFF_PP = OFF_BIG + 320 * MiB, OFF_Y = OFF_BIG + 336 * MiB, OFF_END = OFF_BIG + 400 * MiB;
constexpr size_t OFF_A2 = OFF_QK;
constexpr size_t OFF_X = OFF_END, WS_NEED = OFF_END + 32 * MiB;

enum { I_XP = 0, I_XS, I_STATE, I_C, I_CCTX, I_WADA, I_BADA, I_NORMG, I_FINALG, I_HYWIN, I_HYBIN, I_HYCW, I_HYCB, I_FW1, I_FB1, I_FW2, I_FB2, I_FW3, I_FB3,
       I_FFREQ, I_FWOUT, I_FSKIP, I_HYWOUT, I_HYBOUT, I_WQKVG, I_DECAY, I_GNG, I_WO, I_MW1, I_MW2, N_IN };

struct Params { const float* in[30]; float* out; unsigned char* ws; int ph_lo, ph_hi, dupmask, extrasync; };

#define LDS_WAIT() asm volatile("s_waitcnt lgkmcnt(0)" ::: "memory")
DI unsigned f2bf(float f) { unsigned u = __builtin_bit_cast(unsigned, f); return (u + 0x7fffu + ((u >> 16) & 1u)) >> 16; }
DI unsigned pk2(float lo, float hi) { return f2bf(lo) | (f2bf(hi) << 16); }
DI unsigned cvt_pk(float lo, float hi) { unsigned r; asm volatile("v_cvt_pk_bf16_f32 %0, %1, %2" : "=v"(r) : "v"(lo), "v"(hi)); return r; }
DI float bflo(unsigned w) { return __builtin_bit_cast(float, w << 16); }
DI float bfhi(unsigned w) { return __builtin_bit_cast(float, w & 0xffff0000u); }
DI float bf2f(bf16_t h) { return __builtin_bit_cast(float, ((unsigned)h) << 16); }
DI float wave_sum(float v) {
#pragma unroll
    for (int o = 1; o < 64; o <<= 1) v += __shfl_xor(v, o);
    return v;
}
DI float sin_rev(float rev) { rev = rev - floorf(rev); return __builtin_amdgcn_sinf(rev); }
DI float cos_rev(float rev) { rev = rev - floorf(rev); return __builtin_amdgcn_cosf(rev); }
DI float sin_rad(float x) { return sin_rev(x * 0.15915494309189535f); }
DI float silu_f(float x) { return x / (1.0f + __expf(-x)); }
DI float silu_fast(float x) { return x * __builtin_amdgcn_rcpf(1.0f + __builtin_amdgcn_exp2f(-1.4426950408889634f * x)); }
DI float log2_sigmoid(float logit) { const float e = __expf(-logit); const float l1p = e * (1.0f - e * (0.5f - e * (0.33333333f - 0.25f * e))); return -l1p * 1.4426950408889634f; }
DI u32x4 pack8(f32x4 a, f32x4 b) { u32x4 w; w.x = cvt_pk(a[0], a[1]); w.y = cvt_pk(a[2], a[3]); w.z = cvt_pk(b[0], b[1]); w.w = cvt_pk(b[2], b[3]); return w; }

#define XB_TMO      128
#define XB_XCNT(j)  (256  + 64 * (j))
#define XB_XSUB(j)  (1280 + 64 * (j))
#define XB_XGEN(j)  (2304 + 64 * (j))
#define XB_TOP      3328
#define XB_TOPGEN   3392
#define XCD_BAR_WORDS 3456
#define XB_SPIN_CAP (1u << 18)

__device__ __forceinline__ unsigned xb_ld(unsigned* p)              { return __hip_atomic_load(p, __ATOMIC_RELAXED, __HIP_MEMORY_SCOPE_AGENT); }
__device__ __forceinline__ unsigned xb_add(unsigned* p, unsigned v) { return __hip_atomic_fetch_add(p, v, __ATOMIC_RELAXED, __HIP_MEMORY_SCOPE_AGENT); }
__device__ __forceinline__ unsigned xb_xcc_id() { return (unsigned)__builtin_amdgcn_s_getreg((3 << 11) | 20) & 0xFu; }
#define XB_SPIN(cond, bar) do { unsigned _sp = 0; while (cond) { __builtin_amdgcn_s_sleep(1); \
    if ((++_sp & 255u) == 0u) { if (xb_ld(&(bar)[XB_TMO])) break; if (_sp > XB_SPIN_CAP) { atomicAdd(&(bar)[XB_TMO], 1u); break; } } } } while (0)

struct XcdBarrier {
    unsigned* bar; unsigned x;
    volatile LAS unsigned* st;
};

__device__ __forceinline__ XcdBarrier xcd_barrier_post(unsigned* bar, volatile LAS unsigned* st) {
    XcdBarrier b; b.bar = bar; b.x = xb_xcc_id(); b.st = st;
    if (threadIdx.x == 0) (void)xb_add(&bar[XB_XCNT(b.x)], 1u);
    return b;
}
__device__ __forceinline__ void xcd_barrier_complete(unsigned* bar, unsigned x, unsigned& nloc, unsigned& nx) {
    const unsigned G = gridDim.x * gridDim.y * gridDim.z;
    unsigned sum, cnt, mine, sp = 0u;
    for (;;) {
        sum = 0u; cnt = 0u; mine = 0u;
#pragma unroll
        for (unsigned j = 0; j < 16; ++j) { const unsigned c = xb_ld(&bar[XB_XCNT(j)]); sum += c; cnt += (c > 0u) ? 1u : 0u; mine = (j == x) ? c : mine; }
        if (sum == G) break;
        __builtin_amdgcn_s_sleep(1);
        if ((++sp & 255u) == 0u) { if (xb_ld(&bar[XB_TMO])) break; if (sp > XB_SPIN_CAP) { atomicAdd(&bar[XB_TMO], 1u); break; } }
    }
    nloc = mine > 0u ? mine : 1u; nx = cnt > 0u ? cnt : 1u;
}

__device__ __forceinline__ void xcd_barrier(const XcdBarrier& b) {
    asm volatile("s_waitcnt vmcnt(0)" ::: "memory");
    __syncthreads();
    if (threadIdx.x == 0) {
        unsigned* bar = b.bar;
        __builtin_amdgcn_s_waitcnt(0);
        unsigned nloc = b.st[0], nx = b.st[1];
        if (nloc == 0u) { xcd_barrier_complete(bar, b.x, nloc, nx); b.st[0] = nloc; b.st[1] = nx; }
        const unsigned old = xb_add(&bar[XB_XSUB(b.x)], 1u);
        const unsigned gen = old / nloc;
        if (old + 1u == (gen + 1u) * nloc) {
            __builtin_amdgcn_fence(__ATOMIC_RELEASE, "agent");
            asm volatile("s_waitcnt vmcnt(0)" ::: "memory");
            const unsigned og = xb_add(&bar[XB_TOP], 1u);
            const unsigned tg = og / nx;
            if (og + 1u == (tg + 1u) * nx) xb_add(&bar[XB_TOPGEN], 1u);
            else XB_SPIN(xb_ld(&bar[XB_TOPGEN]) == tg, bar);
            __builtin_amdgcn_fence(__ATOMIC_ACQUIRE, "agent");
            xb_add(&bar[XB_XGEN(b.x)], 1u);
            asm volatile("s_waitcnt vmcnt(0)" ::: "memory");
        } else {
            XB_SPIN(xb_ld(&bar[XB_XGEN(b.x)]) == gen, bar);
            __builtin_amdgcn_fence(__ATOMIC_ACQUIRE, "agent");
            asm volatile("s_waitcnt vmcnt(0)" ::: "memory");
        }
    }
    __syncthreads();
}


namespace g8 {
constexpr int BK = 64, HALF = 128, HTB = HALF * BK * 2;
DI int lds_byte(int r, int c) { const int st = (r >> 4) * 2 + (c >> 5), rr = r & 15, cc = c & 31, ob = rr * 64 + cc * 2; return st * 1024 + (ob ^ (((ob >> 9) & 1) << 5)); }
DI void stage_rc(int b, int& R, int& C) { const int st = b / 1024, sb = b % 1024, swz = sb ^ (((sb >> 9) & 1) << 5); R = (st >> 1) * 16 + swz / 64; C = (st & 1) * 32 + (swz % 64) / 2; }
DI int perm32(int rho) { const int n = rho >> 4, i = rho & 15; return 8 * (i >> 2) + 4 * n + (i & 3); }

enum { EP_PLAIN = 0, EP_PROJ, EP_RELU2, EP_SILU, EP_ADD, EP_F32, EP_RES0, EP_RES, EP_QK, EP_KT, EP_S };
enum { PH_P0 = 0, PH_P1, PH_PROJ, PH_CONV, PH_TR, PH_HYOUT, PH_N1, PH_MLP1A, PH_MLP2A, PH_N2, PH_QKVG, PH_RET1, PH_RET2, PH_GATE, PH_WO, PH_N3, PH_MLP1B, PH_MLP2B, PH_FIN, NPH };

struct Unit { const char* A; const char* B; unsigned lda, ldb; int nt; int kind; int row0, col0; char* out; unsigned ldc; const float* aux; const float* aux2; int h; };

DI void remap(int nM, int nN, int L, int& pm, int& pn) {
    const int nwg = nM * nN; int wgid = L;
    { const int q = nwg / 8, r = nwg % 8, xcd = wgid % 8, off = wgid / 8; wgid = (xcd < r ? xcd * (q + 1) : r * (q + 1) + (xcd - r) * q) + off; }
    const int nig = 8 * nN, gid = wgid / nig, fm = gid * 8, gsz = (nM - fm) < 8 ? (nM - fm) : 8;
    pm = fm + ((wgid % nig) % gsz); pn = (wgid % nig) / gsz;
}

DI bool get_unit(const Params& P, int ph, int idx, Unit& u) {
    unsigned char* ws = P.ws;
    float* mod = (float*)(ws + OFF_MOD);
    u.aux = nullptr; u.aux2 = nullptr; u.h = 0;
    int pm, pn;
    switch (ph) {
    case PH_PROJ: {
        if (idx >= 768) return false;
        remap(24, 32, idx, pm, pn);
        u.A = (const char*)(ws + OFF_WIN) + (size_t)pm * 256 * 2048 * 2; u.lda = 2048;
        u.B = (const char*)(ws + OFF_H) + (size_t)pn * 256 * 2048 * 2; u.ldb = 2048; u.nt = 32;
        u.kind = EP_PROJ; u.out = (char*)(ws + OFF_PROJT); u.ldc = 8192; u.aux = P.in[I_HYBIN]; u.row0 = 256 * pm; u.col0 = 256 * pn;
        return true; }
    case PH_HYOUT: {
        if (idx >= 256) return false;
        remap(32, 8, idx, pm, pn);
        u.A = (const char*)(ws + OFF_Z2) + (size_t)pm * 256 * 2048 * 2; u.lda = 2048;
        u.B = (const char*)(ws + OFF_WHYO) + (size_t)pn * 256 * 2048 * 2; u.ldb = 2048; u.nt = 32;
        u.kind = EP_RES0; u.out = (char*)P.out; u.ldc = 2048; u.aux = mod + 4096; u.aux2 = P.in[I_HYBOUT]; u.row0 = 256 * pm; u.col0 = 256 * pn;
        return true; }
    case PH_MLP1A: case PH_MLP1B: {
        if (idx >= 1024) return false;
        const int l = (ph == PH_MLP1B) ? 1 : 0;
        remap(32, 32, idx, pm, pn);
        u.A = (const char*)(ws + OFF_H) + (size_t)pm * 256 * 2048 * 2; u.lda = 2048;
        u.B = (const char*)(ws + OFF_W1) + ((size_t)l * 8192 + (size_t)pn * 256) * 2048 * 2; u.ldb = 2048; u.nt = 32;
        u.kind = EP_RELU2; u.out = (char*)(ws + OFF_U); u.ldc = 8192; u.row0 = 256 * pm; u.col0 = 256 * pn;
        return true; }
    case PH_MLP2A: case PH_MLP2B: {
        if (idx >= 256) return false;
        const int l = (ph == PH_MLP2B) ? 1 : 0;
        remap(32, 8, idx, pm, pn);
        u.A = (const char*)(ws + OFF_U) + (size_t)pm * 256 * 8192 * 2; u.lda = 8192;
        u.B = (const char*)(ws + OFF_W2) + ((size_t)l * 2048 + (size_t)pn * 256) * 8192 * 2; u.ldb = 8192; u.nt = 128;
        u.kind = EP_RES; u.out = (char*)P.out; u.ldc = 2048; u.aux = mod + l * 61440 + 10240; u.row0 = 256 * pm; u.col0 = 256 * pn;
        return true; }
    case PH_WO: {
        if (idx >= 256) return false;
        remap(32, 8, idx, pm, pn);
        u.A = (const char*)(ws + OFF_A2) + (size_t)pm * 256 * 4096 * 2; u.lda = 4096;
        u.B = (const char*)(ws + OFF_WO) + (size_t)pn * 256 * 4096 * 2; u.ldb = 4096; u.nt = 64;
        u.kind = EP_RES; u.out = (char*)P.out; u.ldc = 2048; u.aux = mod + 61440 + 4096; u.row0 = 256 * pm; u.col0 = 256 * pn;
        return true; }
    case PH_QKVG: {
        if (idx >= 1024) return false;
        const char* Hb = (const char*)(ws + OFF_H); const char* Wq = (const char*)(ws + OFF_WQKVG);
        u.lda = 2048; u.ldb = 2048; u.nt = 32;
        if (idx < 512) { remap(32, 16, idx, pm, pn); if (idx >= 256) pm ^= 16;
            u.A = Hb + (size_t)pm * 256 * 2048 * 2; u.B = Wq + (size_t)pn * 256 * 2048 * 2;
            u.kind = EP_QK; u.out = (char*)(ws + OFF_QK); u.ldc = 4096; u.h = pn & 7;
        } else { remap(16, 32, idx - 512, pm, pn);
            u.A = Wq + (size_t)(4096 + pm * 256) * 2048 * 2; u.B = Hb + (size_t)pn * 256 * 2048 * 2;
            u.kind = EP_PLAIN; u.out = (char*)(ws + OFF_VT); u.ldc = 8192;
        }
        u.row0 = 256 * pm; u.col0 = 256 * pn;
        return true; }
    case PH_RET1: {
        int kt = -1, us = -1;
        if (gridDim.x == 256) {
            if (idx >= 1280) return false;
            const int c = idx & 255, i = idx >> 8;
            if (c < 128) { if (i == 0) kt = c; else if (i <= 2) us = (i - 1) * 128 + c; else return false; }
            else us = 256 + 128 * i + (c - 128);
        } else { if (idx >= 1024) return false; if (idx < 128) kt = idx; else us = idx - 128; }
        const char* QK = (const char*)(ws + OFF_QK);
        if (kt >= 0) {
            remap(8, 16, kt, pm, pn);
            u.A = (const char*)(ws + OFF_WQKVG) + (size_t)(2048 + pm * 256) * 2048 * 2; u.lda = 2048;
            u.B = (const char*)(ws + OFF_H) + (size_t)pn * 256 * 2048 * 2; u.ldb = 2048; u.nt = 32;
            u.kind = EP_KT; u.out = (char*)(ws + OFF_KTF); u.aux = (const float*)(ws + OFF_KTB); u.ldc = 4096; u.h = pm;
        } else if (us < 512) {
            const int bi = us >> 4, rest = us & 15; pm = rest >> 2; pn = rest & 3; const int b = bi >> 3, h = bi & 7; const size_t tok0 = 4096 + (size_t)b * 1024;
            u.A = QK + ((tok0 + 256 * pm) * 4096 + h * 256) * 2; u.lda = 4096;
            u.B = QK + ((tok0 + 256 * pn) * 4096 + 2048 + h * 256) * 2; u.ldb = 4096; u.nt = 4;
            u.kind = EP_S; u.out = (char*)(ws + OFF_PS) + (size_t)bi * 1024 * 1024 * 2; u.ldc = 1024; u.h = h;
        } else if (us < 768) {
            const int l = us - 512, bi = l >> 3, rest = l & 7; pm = rest >> 1; pn = rest & 1; const int b = bi >> 3, h = bi & 7;
            u.A = (const char*)(ws + OFF_QFB) + (((size_t)b * 1024 + 256 * pm) * 4096 + h * 512) * 2; u.lda = 4096;
            u.B = (const char*)(ws + OFF_S0T) + ((size_t)bi * 512 + 256 * pn) * 512 * 2; u.ldb = 512; u.nt = 8;
            u.kind = EP_PLAIN; u.out = (char*)(ws + OFF_Y) + ((4096 + (size_t)b * 1024) * 4096 + h * 512) * 2; u.ldc = 4096;
        } else {
            const int bi = us - 768; pm = 0; pn = 0; const int b = bi >> 3, h = bi & 7; const size_t tok0 = (size_t)b * 256;
            u.A = QK + (tok0 * 4096 + h * 256) * 2; u.lda = 4096;
            u.B = QK + (tok0 * 4096 + 2048 + h * 256) * 2; u.ldb = 4096; u.nt = 4;
            u.kind = EP_S; u.out = (char*)(ws + OFF_PP) + (size_t)bi * 256 * 256 * 2; u.ldc = 256; u.h = h;
        }
        u.row0 = 256 * pm; u.col0 = 256 * pn;
        return true; }
    case PH_RET2: {
        if (idx >= 1536) return false;
        if (idx >= 1024) {
            remap(32, 16, idx - 1024, pm, pn);
            u.A = (const char*)(ws + OFF_H) + (size_t)pm * 256 * 2048 * 2; u.lda = 2048;
            u.B = (const char*)(ws + OFF_WQKVG) + (size_t)(8192 + pn * 256) * 2048 * 2; u.ldb = 2048; u.nt = 32;
            u.kind = EP_SILU; u.out = (char*)(ws + OFF_G); u.ldc = 4096;
            u.row0 = 256 * pm; u.col0 = 256 * pn;
            return true;
        }
        if (idx >= 512) {
            const int l = idx - 512, bi = l >> 1; pm = 0; pn = l & 1; const int b = bi >> 4, h = (bi >> 1) & 7, dir = bi & 1;
            u.A = (const char*)(ws + (dir ? OFF_KTB : OFF_KTF)) + ((size_t)(h * 256) * 4096 + b * 256) * 2; u.lda = 4096;
            u.B = (const char*)(ws + OFF_VT) + ((size_t)(h * 512 + 256 * pn) * 8192 + b * 256) * 2; u.ldb = 8192; u.nt = 4;
            u.kind = EP_F32; u.out = (char*)(P.out + (size_t)NTOK * D + (size_t)((b * 2 + dir) * 8 + h) * 256 * 512); u.ldc = 512;
        } else if (idx < 256) {
            const int bi = idx >> 3, rest = idx & 7; pm = rest >> 1; pn = rest & 1; const int b = bi >> 3, h = bi & 7;
            u.A = (const char*)(ws + OFF_PS) + ((size_t)bi * 1024 * 1024 + (size_t)256 * pm * 1024) * 2; u.lda = 1024;
            u.B = (const char*)(ws + OFF_VT) + ((size_t)(h * 512 + 256 * pn) * 8192 + 4096 + b * 1024) * 2; u.ldb = 8192; u.nt = 16;
            u.kind = EP_ADD; u.out = (char*)(ws + OFF_Y) + ((4096 + (size_t)b * 1024) * 4096 + h * 512) * 2; u.ldc = 4096;
        } else {
            const int l = idx - 256, bi = l >> 1; pm = 0; pn = l & 1; const int b = bi >> 3, h = bi & 7;
            u.A = (const char*)(ws + OFF_PP) + (size_t)bi * 65536 * 2; u.lda = 256;
            u.B = (const char*)(ws + OFF_VT) + ((size_t)(h * 512 + 256 * pn) * 8192 + b * 256) * 2; u.ldb = 8192; u.nt = 4;
            u.kind = EP_PLAIN; u.out = (char*)(ws + OFF_Y) + (((size_t)b * 256) * 4096 + h * 512) * 2; u.ldc = 4096;
        }
        u.row0 = 256 * pm; u.col0 = 256 * pn;
        return true; }
    default: return false;
    }
}

DI void epilogue(const Params& P, const Unit& u, const f32x4 (&acc)[2][2][4][2], int wr, int wc, int fr, int fq) {
#define EPI_BEGIN _Pragma("unroll") for (int ai = 0; ai < 2; ++ai) _Pragma("unroll") for (int m = 0; m < 4; ++m) { const int r = u.row0 + ai * 128 + wr * 64 + m * 16 + fr; \
        _Pragma("unroll") for (int bj = 0; bj < 2; ++bj) { const int c = u.col0 + bj * 128 + wc * 32 + 8 * fq; f32x4 v0 = acc[ai][bj][m][0], v1 = acc[ai][bj][m][1];
#define EPI_END } }
    switch (u.kind) {
    case EP_PLAIN: {
        EPI_BEGIN
            *(u32x4*)(u.out + ((size_t)r * u.ldc + c) * 2) = pack8(v0, v1);
        EPI_END
    } break;
    case EP_PROJ: {
        float rb[2][4];
#pragma unroll
        for (int ai = 0; ai < 2; ++ai)
#pragma unroll
            for (int m = 0; m < 4; ++m) rb[ai][m] = u.aux[u.row0 + ai * 128 + wr * 64 + m * 16 + fr];
        EPI_BEGIN
            const float b = rb[ai][m]; v0 = v0 + b; v1 = v1 + b;
            *(u32x4*)(u.out + ((size_t)r * u.ldc + c) * 2) = pack8(v0, v1);
        EPI_END
    } break;
    case EP_RELU2: {
        EPI_BEGIN
#pragma unroll
            for (int e = 0; e < 4; ++e) { float a = fmaxf(v0[e], 0.f), b = fmaxf(v1[e], 0.f); v0[e] = a * a; v1[e] = b * b; }
            *(u32x4*)(u.out + ((size_t)r * u.ldc + c) * 2) = pack8(v0, v1);
        EPI_END
    } break;
    case EP_SILU: {
        EPI_BEGIN
#pragma unroll
            for (int e = 0; e < 4; ++e) { v0[e] = silu_fast(v0[e]); v1[e] = silu_fast(v1[e]); }
            *(u32x4*)(u.out + ((size_t)r * u.ldc + c) * 2) = pack8(v0, v1);
        EPI_END
    } break;
    case EP_ADD: {
#pragma unroll
        for (int bj = 0; bj < 2; ++bj) {
            const int c = u.col0 + bj * 128 + wc * 32 + 8 * fq;
#pragma unroll
            for (int ai = 0; ai < 2; ++ai) {
                u32x4 o[4];
#pragma unroll
                for (int m = 0; m < 4; ++m) { const int r = u.row0 + ai * 128 + wr * 64 + m * 16 + fr; o[m] = *(const u32x4*)(u.out + ((size_t)r * u.ldc + c) * 2); }
#pragma unroll
                for (int m = 0; m < 4; ++m) { const int r = u.row0 + ai * 128 + wr * 64 + m * 16 + fr; f32x4 v0 = acc[ai][bj][m][0], v1 = acc[ai][bj][m][1];
                    v0[0] += bflo(o[m].x); v0[1] += bfhi(o[m].x); v0[2] += bflo(o[m].y); v0[3] += bfhi(o[m].y); v1[0] += bflo(o[m].z); v1[1] += bfhi(o[m].z); v1[2] += bflo(o[m].w); v1[3] += bfhi(o[m].w);
                    *(u32x4*)(u.out + ((size_t)r * u.ldc + c) * 2) = pack8(v0, v1); }
            }
        }
    } break;
    case EP_F32: {
        EPI_BEGIN
            f32x4* p = (f32x4*)(u.out + ((size_t)r * u.ldc + c) * 4); __builtin_nontemporal_store(v0, p); __builtin_nontemporal_store(v1, p + 1);
        EPI_END
    } break;
    case EP_RES0: case EP_RES: {
        const bool first = (u.kind == EP_RES0);
        bf16_t* xb = (bf16_t*)(P.ws + OFF_X);
        const int cond = u.row0 < NPT ? 0 : 1 + ((u.row0 - NPT) >> 10);
#pragma unroll
        for (int bj = 0; bj < 2; ++bj) {
            const int c = u.col0 + bj * 128 + wc * 32 + 8 * fq;
            const f32x4* gp = (const f32x4*)(u.aux + (size_t)cond * 12288 + c); const f32x4 g0 = gp[0], g1 = gp[1];
            f32x4 b0 = (f32x4){0.f, 0.f, 0.f, 0.f}, b1 = b0;
            if (u.aux2) { const f32x4* bp = (const f32x4*)(u.aux2 + c); b0 = bp[0] * g0; b1 = bp[1] * g1; }
#pragma unroll
            for (int ai = 0; ai < 2; ++ai) {
                f32x4 x0[4], x1[4];
                if (first) {
#pragma unroll
                    for (int m = 0; m < 4; ++m) { const int r = u.row0 + ai * 128 + wr * 64 + m * 16 + fr;
                        const f32x4* xi = (const f32x4*)((r < NPT ? P.in[I_XP] + (size_t)r * 2048 : P.in[I_XS] + (size_t)(r - NPT) * 2048) + c); x0[m] = xi[0]; x1[m] = xi[1]; }
                } else {
                    u32x4 o[4];
#pragma unroll
                    for (int m = 0; m < 4; ++m) { const int r = u.row0 + ai * 128 + wr * 64 + m * 16 + fr; o[m] = *(const u32x4*)(xb + (size_t)r * 2048 + c); }
#pragma unroll
                    for (int m = 0; m < 4; ++m) { x0[m] = (f32x4){bflo(o[m].x), bfhi(o[m].x), bflo(o[m].y), bfhi(o[m].y)}; x1[m] = (f32x4){bflo(o[m].z), bfhi(o[m].z), bflo(o[m].w), bfhi(o[m].w)}; }
                }
#pragma unroll
                for (int m = 0; m < 4; ++m) { const int r = u.row0 + ai * 128 + wr * 64 + m * 16 + fr;
                    *(u32x4*)(xb + (size_t)r * 2048 + c) = pack8(x0[m] + b0 + g0 * acc[ai][bj][m][0], x1[m] + b1 + g1 * acc[ai][bj][m][1]); }
            }
        }
    } break;
    case EP_QK: {
        const bool isk = u.col0 >= 2048; const int hd = u.h;
        const float lgf = log2_sigmoid(P.in[I_DECAY][hd]), lgb = log2_sigmoid(P.in[I_DECAY][8 + hd]);
        bf16_t* qfb = (bf16_t*)(P.ws + OFF_QFB);
        const bool samp = u.row0 >= NPT;
        float invr[2][4];
#pragma unroll
        for (int bj = 0; bj < 2; ++bj) { const int p0 = ((bj * 128 + wc * 32 + 8 * fq) & 255) >> 1;
#pragma unroll
            for (int e = 0; e < 4; ++e) invr[bj][e] = __builtin_amdgcn_exp2f(-(float)((p0 + e) & 63) * 0.20762050593046014f) * 0.15915494309189535f; }
#pragma unroll
        for (int ai = 0; ai < 2; ++ai)
#pragma unroll
            for (int m = 0; m < 4; ++m) {
                const int r = u.row0 + ai * 128 + wr * 64 + m * 16 + fr;
                const int t = (r - NPT) & 1023;
                const float prow = (float)(t >> 6), pcol = (float)(t & 63);
                const float gf = __builtin_amdgcn_exp2f(lgf * (float)(t + 1)), gb = __builtin_amdgcn_exp2f(lgb * (float)(1024 - t));
#pragma unroll
                for (int bj = 0; bj < 2; ++bj) {
                    const int c = u.col0 + bj * 128 + wc * 32 + 8 * fq; const f32x4 v0 = acc[ai][bj][m][0], v1 = acc[ai][bj][m][1];
                    float v[8] = {v0[0], v0[1], v0[2], v0[3], v1[0], v1[1], v1[2], v1[3]};
                    const int dkk = c & 255;
                    if (samp) {
                        const float posv = (dkk < 128) ? prow : pcol;
#pragma unroll
                        for (int e = 0; e < 4; ++e) { const float rev = posv * invr[bj][e]; const float sn = sin_rev(rev), cs = cos_rev(rev);
                            const float a = v[2 * e], b = v[2 * e + 1]; v[2 * e] = a * cs - b * sn; v[2 * e + 1] = a * sn + b * cs; }
                    }
                    if (isk) {
#pragma unroll
                        for (int e = 0; e < 8; ++e) v[e] *= 0.0625f;
                    }
                    u32x4 w; w.x = cvt_pk(v[0], v[1]); w.y = cvt_pk(v[2], v[3]); w.z = cvt_pk(v[4], v[5]); w.w = cvt_pk(v[6], v[7]);
                    *(u32x4*)(u.out + ((size_t)r * 4096 + c) * 2) = w;
                    if (!isk && samp) {
                        bf16_t* q0 = qfb + (size_t)(r - NPT) * 4096 + hd * 512 + dkk;
                        u32x4 wf, wb; wf.x = cvt_pk(v[0] * gf, v[1] * gf); wf.y = cvt_pk(v[2] * gf, v[3] * gf); wf.z = cvt_pk(v[4] * gf, v[5] * gf); wf.w = cvt_pk(v[6] * gf, v[7] * gf);
                        wb.x = cvt_pk(v[0] * gb, v[1] * gb); wb.y = cvt_pk(v[2] * gb, v[3] * gb); wb.z = cvt_pk(v[4] * gb, v[5] * gb); wb.w = cvt_pk(v[6] * gb, v[7] * gb);
                        *(u32x4*)q0 = wf; *(u32x4*)(q0 + 256) = wb;
                    }
                }
            }
    } break;
    case EP_KT: {
        const int hd = u.h;
        const float lgf = log2_sigmoid(P.in[I_DECAY][hd]), lgb = log2_sigmoid(P.in[I_DECAY][8 + hd]);
        char* outb = (char*)u.aux;
        EPI_BEGIN
            const int t0 = c & 255; float vf[8], vb[8];
#pragma unroll
            for (int e = 0; e < 8; ++e) { const float x = (e < 4 ? v0[e & 3] : v1[e & 3]) * 0.0625f; const int t = t0 + e;
                vf[e] = x * __builtin_amdgcn_exp2f(lgf * (float)(255 - t)); vb[e] = x * __builtin_amdgcn_exp2f(lgb * (float)t); }
            u32x4 wf, wb; wf.x = cvt_pk(vf[0], vf[1]); wf.y = cvt_pk(vf[2], vf[3]); wf.z = cvt_pk(vf[4], vf[5]); wf.w = cvt_pk(vf[6], vf[7]);
            wb.x = cvt_pk(vb[0], vb[1]); wb.y = cvt_pk(vb[2], vb[3]); wb.z = cvt_pk(vb[4], vb[5]); wb.w = cvt_pk(vb[6], vb[7]);
            *(u32x4*)(u.out + ((size_t)r * 4096 + c) * 2) = wf; *(u32x4*)(outb + ((size_t)r * 4096 + c) * 2) = wb;
        EPI_END
    } break;
    case EP_S: {
        const int hd = u.h;
        const float lgf = log2_sigmoid(P.in[I_DECAY][hd]), lgb = log2_sigmoid(P.in[I_DECAY][8 + hd]);
        EPI_BEGIN
            float v[8];
#pragma unroll
            for (int e = 0; e < 8; ++e) { const float x = (e < 4 ? v0[e & 3] : v1[e & 3]); const int dlt = r - (c + e);
                const float ar = dlt > 0 ? lgf * (float)dlt : lgb * (float)(-dlt);
                float mk = __builtin_amdgcn_exp2f(ar); mk = dlt == 0 ? 2.0f : mk; v[e] = x * mk; }
            u32x4 w; w.x = cvt_pk(v[0], v[1]); w.y = cvt_pk(v[2], v[3]); w.z = cvt_pk(v[4], v[5]); w.w = cvt_pk(v[6], v[7]);
            *(u32x4*)(u.out + ((size_t)r * u.ldc + c) * 2) = w;
        EPI_END
    } break;
    default: break;
    }
#undef EPI_BEGIN
#undef EPI_END
}

DI void gemm_phase(LAS unsigned char* lds, const Params& P, int ph, const int tid, const int rep) {
    const int wid = __builtin_amdgcn_readfirstlane(tid >> 6), lane = tid & 63, wr = wid >> 2, wc = wid & 3, fr = lane & 15, fq = lane >> 4;
    const int G = gridDim.x, bid = blockIdx.x + ((rep && ph == PH_RET2) ? 256 : 0);
    int sR0, sC0; stage_rc(tid * 16, sR0, sC0);
    const int sB0 = (sR0 & ~31) + perm32(sR0 & 31);
    const unsigned ldsw = (unsigned)wid * 1024u;
    const int aoff = lds_byte(wr * 64 + fr, fq * 8), boff = lds_byte(wc * 32 + fr, fq * 8);
#define G8_SA(b, h) (((b) * 2 + (h)) * HTB)
#define G8_SB(b, h) ((4 + (b) * 2 + (h)) * HTB)
#define G8_STAGE(bufoff, gbase, V0, V1) do { \
        __builtin_amdgcn_global_load_lds((const unsigned*)((const char*)(gbase) + (V0)), (LAS unsigned*)(lds + (bufoff) + ldsw), 16, 0, 0); \
        __builtin_amdgcn_global_load_lds((const unsigned*)((const char*)(gbase) + (V1)), (LAS unsigned*)(lds + (bufoff) + ldsw + 8192), 16, 0, 0); } while (0)
#define G8_LDA(dst, b, h) do { _Pragma("unroll") for (int m = 0; m < 4; ++m) _Pragma("unroll") for (int k = 0; k < 2; ++k) dst[m][k] = *(const LAS bf16x8*)(lds + G8_SA(b, h) + aoff + m * 2048 + k * 1024); } while (0)
#define G8_LDB(dst, b, h) do { _Pragma("unroll") for (int n = 0; n < 2; ++n) _Pragma("unroll") for (int k = 0; k < 2; ++k) dst[n][k] = *(const LAS bf16x8*)(lds + G8_SB(b, h) + boff + n * 2048 + k * 1024); } while (0)
#define G8_MMA(ai, bj, At, Bt) do { __builtin_amdgcn_s_setprio(1); _Pragma("unroll") for (int m = 0; m < 4; ++m) _Pragma("unroll") for (int n = 0; n < 2; ++n) _Pragma("unroll") for (int k = 0; k < 2; ++k) \
        acc[ai][bj][m][n] = __builtin_amdgcn_mfma_f32_16x16x32_bf16(Bt[n][k], At[m][k], acc[ai][bj][m][n], 0, 0, 0); __builtin_amdgcn_s_setprio(0); } while (0)
#define G8_WAIT_V(n) asm volatile("s_waitcnt vmcnt(" #n ")" ::: "memory")
#define G8_WAIT_L(n) asm volatile("s_waitcnt lgkmcnt(" #n ")" ::: "memory")
#define G8_BAR __builtin_amdgcn_s_barrier()
#define G8_SCHED __builtin_amdgcn_sched_barrier(0)
    int ui = 0;
    const char* cA; const char* cB; unsigned clda, cldb; int nt;
    { Unit u0; if (!get_unit(P, ph, bid, u0)) return; cA = u0.A; cB = u0.B; clda = u0.lda; cldb = u0.ldb; nt = u0.nt; }
    f32x4 acc[2][2][4][2];
#pragma unroll
    for (int a = 0; a < 2; ++a)
#pragma unroll
        for (int b = 0; b < 2; ++b)
#pragma unroll
            for (int m = 0; m < 4; ++m)
#pragma unroll
                for (int n = 0; n < 2; ++n) acc[a][b][m][n] = (f32x4){0.f, 0.f, 0.f, 0.f};
    bf16x8 At[4][2], B0[2][2], B1[2][2];
    const size_t kstep = 128;
#define VOA0(ld) ((unsigned)(sR0 * (int)(ld) + sC0) * 2u)
#define VOA1(ld) ((unsigned)((sR0 + 64) * (int)(ld) + sC0) * 2u)
#define VOB0(ld) ((unsigned)(sB0 * (int)(ld) + sC0) * 2u)
#define VOB1(ld) ((unsigned)((sB0 + 64) * (int)(ld) + sC0) * 2u)
    { const size_t chA = (size_t)HALF * clda * 2, chB = (size_t)HALF * cldb * 2;
    G8_STAGE(G8_SB(0, 0), cB, VOB0(cldb), VOB1(cldb)); G8_STAGE(G8_SB(0, 1), cB + chB, VOB0(cldb), VOB1(cldb)); G8_STAGE(G8_SA(0, 0), cA, VOA0(clda), VOA1(clda)); G8_STAGE(G8_SA(0, 1), cA + chA, VOA0(clda), VOA1(clda));
    if (wr == 1) G8_BAR;
    G8_WAIT_V(2); G8_BAR;
    G8_STAGE(G8_SB(1, 0), cB + kstep, VOB0(cldb), VOB1(cldb)); G8_STAGE(G8_SA(1, 0), cA + kstep, VOA0(clda), VOA1(clda)); G8_STAGE(G8_SB(1, 1), cB + chB + kstep, VOB0(cldb), VOB1(cldb));
    G8_WAIT_V(6); G8_BAR; }
    for (;;) {
        const char* nA; const char* nB; unsigned nlda, nldb; int nnt; bool has_next;
        { Unit un; has_next = get_unit(P, ph, bid + (ui + 1) * G, un);
          nA = has_next ? un.A : cA; nB = has_next ? un.B : cB; nlda = has_next ? un.lda : clda; nldb = has_next ? un.ldb : cldb; nnt = has_next ? un.nt : nt; }
        const size_t chA = (size_t)HALF * clda * 2;
        for (int t = 0; t < nt; t += 2) {
            const bool last = (t == nt - 2);
            const char* a1 = cA + (size_t)(t + 1) * kstep;
            const char* a2 = last ? nA : cA + (size_t)(t + 2) * kstep; const char* b2 = last ? nB : cB + (size_t)(t + 2) * kstep;
            const char* a3 = a2 + kstep; const char* b3 = b2 + kstep;
            const unsigned lda2 = last ? nlda : clda, ldb2 = last ? nldb : cldb;
            const size_t hA2 = (size_t)HALF * lda2 * 2, hB2 = (size_t)HALF * ldb2 * 2;
            G8_LDB(B0, 0, 0); G8_LDB(B1, 0, 1); G8_SCHED; G8_LDA(At, 0, 0); G8_STAGE(G8_SA(1, 1), a1 + chA, VOA0(clda), VOA1(clda));
            G8_WAIT_V(8); G8_WAIT_L(0); G8_BAR; G8_MMA(0, 0, At, B0); G8_MMA(0, 1, At, B1); G8_BAR; G8_SCHED;
            G8_LDA(At, 0, 1); G8_STAGE(G8_SB(0, 0), b2, VOB0(ldb2), VOB1(ldb2)); G8_STAGE(G8_SB(0, 1), b2 + hB2, VOB0(ldb2), VOB1(ldb2)); G8_STAGE(G8_SA(0, 0), a2, VOA0(lda2), VOA1(lda2));
            G8_WAIT_V(8); G8_WAIT_L(0); G8_BAR; G8_MMA(1, 0, At, B0); G8_MMA(1, 1, At, B1); G8_BAR; G8_SCHED;
            G8_LDB(B0, 1, 0); G8_LDB(B1, 1, 1); G8_SCHED; G8_LDA(At, 1, 0); G8_STAGE(G8_SA(0, 1), a2 + hA2, VOA0(lda2), VOA1(lda2));
            G8_WAIT_V(8); G8_WAIT_L(0); G8_BAR; G8_MMA(0, 0, At, B0); G8_MMA(0, 1, At, B1); G8_BAR; G8_SCHED;
            G8_LDA(At, 1, 1); G8_STAGE(G8_SB(1, 0), b3, VOB0(ldb2), VOB1(ldb2)); G8_STAGE(G8_SB(1, 1), b3 + hB2, VOB0(ldb2), VOB1(ldb2)); G8_STAGE(G8_SA(1, 0), a3, VOA0(lda2), VOA1(lda2));
            G8_WAIT_V(8); G8_WAIT_L(0); G8_BAR; G8_MMA(1, 0, At, B0); G8_MMA(1, 1, At, B1); G8_BAR; G8_SCHED;
        }
        if (wr == 0) G8_BAR;
        { Unit uc; get_unit(P, ph, bid + ui * G, uc); int efr = fr, efq = fq; asm volatile("" : "+v"(efr), "+v"(efq)); epilogue(P, uc, acc, wr, wc, efr, efq); }
        if (!has_next) break;
#pragma unroll
        for (int a = 0; a < 2; ++a)
#pragma unroll
            for (int b = 0; b < 2; ++b)
#pragma unroll
                for (int m = 0; m < 4; ++m)
#pragma unroll
                    for (int n = 0; n < 2; ++n) acc[a][b][m][n] = (f32x4){0.f, 0.f, 0.f, 0.f};
        cA = nA; cB = nB; clda = nlda; cldb = nldb; nt = nnt; ++ui;
        if (wr == 1) G8_BAR;
    }
    G8_WAIT_V(0);
    G8_BAR;
}
}

DI void tr_item(const float* W, int N, bf16_t* WT, int ldo, LAS float* scr, int kb, int nb, int lane) {
    const int k0 = 64 * kb, n0 = 32 * nb;
#pragma unroll 8
    for (int i = 0; i < 32; ++i) { const int kk = 2 * i + (lane >> 5); scr[kk * 33 + (lane & 31)] = __builtin_nontemporal_load(&W[(size_t)(k0 + kk) * N + n0 + (lane & 31)]); }
    LDS_WAIT();
    const int c = lane & 7;
#pragma unroll
    for (int j = 0; j < 4; ++j) { const int n = (lane >> 3) + 8 * j; const LAS float* s = scr + (8 * c) * 33 + n;
        u32x4 o; o.x = pk2(s[0 * 33], s[1 * 33]); o.y = pk2(s[2 * 33], s[3 * 33]); o.z = pk2(s[4 * 33], s[5 * 33]); o.w = pk2(s[6 * 33], s[7 * 33]);
        *(u32x4*)(WT + (size_t)(n0 + n) * ldo + k0 + 8 * c) = o; }
    LDS_WAIT();
}
DI void tr_matrix_item(const float* W, int K, int N, bf16_t* WT, int ldo, LAS float* scr, int item, int lane) {
    const int nblk = N / 32; tr_item(W, N, WT, ldo, scr, item / nblk, item % nblk, lane);
}

DI void p0_phase(LAS unsigned char* lds, const Params& P, const int tid, const int rep) {
    const int lane = tid & 63, wave = __builtin_amdgcn_readfirstlane(tid >> 6);
    const int gw = blockIdx.x * NWAVES + wave, NGW = gridDim.x * NWAVES;
    unsigned char* ws = P.ws;
    for (int pos = gw; pos < 1280; pos += NGW) {
        const int L = pos < 256 ? 256 : 1024; const int pp = pos < 256 ? pos : pos - 256;
        const float tt = (float)pp / (float)L;
        float feat = 0.f;
        if (lane == 0) feat = tt;
        else if (lane <= 32) { const int bi = (lane - 1) & 15; const float band = 1e-4f + (float)bi * ((15.0f - 1e-4f) / 15.0f); const float rev = tt * band;
            feat = (lane <= 16) ? cos_rev(rev) : -sin_rev(rev); }
        const float* w1 = P.in[I_FW1]; const float* w2 = P.in[I_FW2]; const float* w3 = P.in[I_FW3]; const float* fq = P.in[I_FFREQ];
        float a = P.in[I_FB1][lane];
#pragma unroll 3
        for (int e = 0; e < 33; ++e) { const float f = __builtin_bit_cast(float, __builtin_amdgcn_readlane(__builtin_bit_cast(int, feat), e)); a += f * w1[e * 64 + lane]; }
        float h1 = sin_rad(fq[lane] * a);
        a = P.in[I_FB2][lane];
#pragma unroll 8
        for (int e = 0; e < 64; ++e) { const float f = __builtin_bit_cast(float, __builtin_amdgcn_readlane(__builtin_bit_cast(int, h1), e)); a += f * w2[e * 64 + lane]; }
        float h2 = sin_rad(fq[64 + lane] * a);
        a = P.in[I_FB3][lane];
#pragma unroll 8
        for (int e = 0; e < 64; ++e) { const float f = __builtin_bit_cast(float, __builtin_amdgcn_readlane(__builtin_bit_cast(int, h2), e)); a += f * w3[e * 64 + lane]; }
        const float h3 = sin_rad(fq[128 + lane] * a);
        ((float*)(ws + OFF_H3))[pos * 64 + lane] = h3;
    }
    for (int item = gw; item < (rep ? 0 : 1536); item += NGW) {
        const int layer = item / 768, rem = item % 768, nchunk = rem >> 4, kc = rem & 15, n0 = nchunk * 256, k0 = kc * 128;
        const float* W = P.in[I_WADA] + (size_t)layer * 2048 * 12288;
        f32x4 acc[5];
#pragma unroll
        for (int j = 0; j < 5; ++j) acc[j] = (f32x4){0.f, 0.f, 0.f, 0.f};
#pragma unroll 1
        for (int half = 0; half < 2; ++half) {
            const int kb = k0 + half * 64;
            float av[5];
            av[0] = silu_f(P.in[I_CCTX][kb + lane]);
#pragma unroll
            for (int j = 1; j < 5; ++j) av[j] = silu_f(P.in[I_C][(j - 1) * 2048 + kb + lane]);
#pragma unroll 8
            for (int kk = 0; kk < 64; ++kk) {
                const f32x4 w = __builtin_nontemporal_load((const f32x4*)(W + (size_t)(kb + kk) * 12288 + n0 + 4 * lane));
#pragma unroll
                for (int j = 0; j < 5; ++j) { const float s = __builtin_bit_cast(float, __builtin_amdgcn_readlane(__builtin_bit_cast(int, av[j]), kk)); acc[j] = acc[j] + w * s; }
            }
        }
        float* mod = (float*)(ws + OFF_MOD);
#pragma unroll
        for (int j = 0; j < 5; ++j) {
            if (kc == 0) acc[j] = acc[j] + *(const f32x4*)(P.in[I_BADA] + layer * 12288 + n0 + 4 * lane);
            float* o = mod + (size_t)(layer * 5 + j) * 12288 + n0 + 4 * lane;
            atomicAdd(o + 0, acc[j][0]); atomicAdd(o + 1, acc[j][1]); atomicAdd(o + 2, acc[j][2]); atomicAdd(o + 3, acc[j][3]);
        }
    }
    LAS float* scr = (LAS float*)(lds + wave * 16384);
    constexpr int I_A = 32 * 192, I_B = 32 * 64, I_C2 = 32 * 384, I_D = 64 * 64, I_E = 32 * 256, I_F = 128 * 64, I_S = 64 * 64;
    constexpr int NITEMS = I_A + I_B + I_C2 + I_D + 2 * I_E + 2 * I_F + I_S;
    const bool bal = (NGW == 2048); constexpr int PART_A = 1536 * 27;
    const int it0 = !bal ? gw : (gw < 1536 ? gw : PART_A + (gw - 1536)), its = !bal ? NGW : (gw < 1536 ? 1536 : 512), ite = (!bal || gw >= 1536) ? NITEMS : PART_A;
    for (int it = it0; it < ite; it += its) {
        int r = NITEMS - 1 - it;
        if (r < I_A) { tr_matrix_item(P.in[I_HYWIN], 2048, 6144, (bf16_t*)(ws + OFF_WIN), 2048, scr, r, lane); continue; } r -= I_A;
        if (r < I_B) { tr_matrix_item(P.in[I_HYWOUT], 2048, 2048, (bf16_t*)(ws + OFF_WHYO), 2048, scr, r, lane); continue; } r -= I_B;
        if (r < I_C2) { tr_matrix_item(P.in[I_WQKVG], 2048, 12288, (bf16_t*)(ws + OFF_WQKVG), 2048, scr, r, lane); continue; } r -= I_C2;
        if (r < I_D) { tr_matrix_item(P.in[I_WO], 4096, 2048, (bf16_t*)(ws + OFF_WO), 4096, scr, r, lane); continue; } r -= I_D;
        if (r < 2 * I_E) { const int l = r / I_E; tr_matrix_item(P.in[I_MW1] + (size_t)l * 2048 * 8192, 2048, 8192, (bf16_t*)(ws + OFF_W1) + (size_t)l * 8192 * 2048, 2048, scr, r % I_E, lane); continue; } r -= 2 * I_E;
        if (r < 2 * I_F) { const int l = r / I_F; tr_matrix_item(P.in[I_MW2] + (size_t)l * 8192 * 2048, 8192, 2048, (bf16_t*)(ws + OFF_W2) + (size_t)l * 2048 * 8192, 8192, scr, r % I_F, lane); continue; } r -= 2 * I_F;
        { const int mi = r >> 6, sub = r & 63; const int b = mi >> 4, dir = (mi >> 3) & 1, h = mi & 7;
          tr_matrix_item(P.in[I_STATE] + (size_t)mi * 256 * 512, 256, 512, (bf16_t*)(ws + OFF_S0T) + (size_t)(b * 8 + h) * 512 * 512 + dir * 256, 512, scr, sub, lane); }
    }
}

DI void norm_rows(const Params& P, int mode, const int tid, const int row0, const int rowend, const int gw, const int NGW) {
    const int lane = tid & 63;
    const float* mod = (const float*)(P.ws + OFF_MOD);
    const int layer = (mode >= 2 && mode < 4) ? 1 : 0, which = mode & 1;
    const float* gvec = (mode == 4) ? P.in[I_FINALG] : P.in[I_NORMG] + (layer * 2 + which) * 2048;
    for (int row = row0 + gw; row < rowend; row += NGW) {
        f32x4 v[8]; float ss = 0.f;
        if (mode == 0) {
            const float* src = row < NPT ? P.in[I_XP] + (size_t)row * 2048 : P.in[I_XS] + (size_t)(row - NPT) * 2048;
            const f32x4* xr = (const f32x4*)src + lane;
#pragma unroll
            for (int j = 0; j < 8; ++j) v[j] = xr[64 * j];
        } else {
            const u32x2* xr = (const u32x2*)((const bf16_t*)(P.ws + OFF_X) + (size_t)row * 2048) + lane;
#pragma unroll
            for (int j = 0; j < 8; ++j) { const u32x2 w = __builtin_nontemporal_load(xr + 64 * j); v[j] = (f32x4){bflo(w.x), bfhi(w.x), bflo(w.y), bfhi(w.y)}; }
        }
#pragma unroll
        for (int j = 0; j < 8; ++j) ss += (v[j][0] * v[j][0] + v[j][1] * v[j][1]) + (v[j][2] * v[j][2] + v[j][3] * v[j][3]);
        const float rstd = 1.0f / sqrtf(wave_sum(ss) * (1.0f / 2048.0f) + EPS);
        f32x4 gq[8];
#pragma unroll
        for (int j = 0; j < 8; ++j) gq[j] = *((const f32x4*)gvec + lane + 64 * j);
        if (mode == 4) {
            f32x4* o = (f32x4*)(P.out + (size_t)row * 2048) + lane;
#pragma unroll
            for (int j = 0; j < 8; ++j) __builtin_nontemporal_store(v[j] * rstd * gq[j], o + 64 * j);
        } else {
            const int cond = row < NPT ? 0 : 1 + ((row - NPT) >> 10);
            const float* sh = mod + (size_t)layer * 61440 + (size_t)cond * 12288 + (which ? 6144 : 0); const float* sc = sh + 2048;
            u32x2* o = (u32x2*)((bf16_t*)(P.ws + OFF_H) + (size_t)row * 2048) + lane;
            f32x4 s1q[8], s0q[8];
#pragma unroll
            for (int j = 0; j < 8; ++j) { s1q[j] = *((const f32x4*)sc + lane + 64 * j); s0q[j] = *((const f32x4*)sh + lane + 64 * j); }
#pragma unroll
            for (int j = 0; j < 8; ++j) { const f32x4 y = v[j] * rstd * gq[j] * (s1q[j] + 1.0f) + s0q[j]; u32x2 w; w.x = cvt_pk(y[0], y[1]); w.y = cvt_pk(y[2], y[3]); o[64 * j] = w; }
        }
    }
}

DI void norm_phase(const Params& P, int mode, const int tid) { norm_rows(P, mode, tid, 0, NTOK, blockIdx.x * NWAVES + (tid >> 6), gridDim.x * NWAVES); }
DI void panel_norm(const Params& P, int mode, const int tid) {
    const int lane = tid & 63, wave = tid >> 6;
    int pm, pn; g8::remap(32, 8, blockIdx.x, pm, pn);
    const int layer = (mode >= 2) ? 1 : 0, which = mode & 1;
    const int r0 = pm * 256 + pn * 32; const int cond = r0 < NPT ? 0 : 1 + ((r0 - NPT) >> 10);
    const float* gvec = P.in[I_NORMG] + (layer * 2 + which) * 2048;
    const float* sh = (const float*)(P.ws + OFF_MOD) + (size_t)layer * 61440 + (size_t)cond * 12288 + (which ? 6144 : 0); const float* sc = sh + 2048;
    f32x4 wq[8], sq[8];
#pragma unroll
    for (int j = 0; j < 8; ++j) { const f32x4 g = *((const f32x4*)gvec + lane + 64 * j), s1 = *((const f32x4*)sc + lane + 64 * j); sq[j] = *((const f32x4*)sh + lane + 64 * j); wq[j] = g * (s1 + 1.0f); }
    unsigned* cnt = (unsigned*)(P.ws + OFF_PCNT) + ((mode - 1) * 32 + pm) * 64;
    if (tid == 0) {
        __builtin_amdgcn_fence(__ATOMIC_RELEASE, "agent");
        asm volatile("s_waitcnt vmcnt(0)" ::: "memory");
        (void)__hip_atomic_fetch_add(cnt, 1u, __ATOMIC_RELAXED, __HIP_MEMORY_SCOPE_AGENT);
        unsigned sp = 0;
        while (__hip_atomic_load(cnt, __ATOMIC_RELAXED, __HIP_MEMORY_SCOPE_AGENT) < 8u) { __builtin_amdgcn_s_sleep(1); if (++sp > (1u << 20)) break; }
        __builtin_amdgcn_fence(__ATOMIC_ACQUIRE, "agent");
        asm volatile("s_waitcnt vmcnt(0)" ::: "memory");
    }
    __syncthreads();
    const int rw = r0 + wave * 4;
    u32x2 xq[4][8];
#pragma unroll
    for (int i = 0; i < 4; ++i) { const u32x2* xr = (const u32x2*)((const bf16_t*)(P.ws + OFF_X) + (size_t)(rw + i) * 2048) + lane;
#pragma unroll
        for (int j = 0; j < 8; ++j) xq[i][j] = xr[64 * j]; }
    float rs[4];
#pragma unroll
    for (int i = 0; i < 4; ++i) { float ss = 0.f;
#pragma unroll
        for (int j = 0; j < 8; ++j) { const float a = bflo(xq[i][j].x), b = bfhi(xq[i][j].x), c = bflo(xq[i][j].y), d = bfhi(xq[i][j].y); ss += (a * a + b * b) + (c * c + d * d); }
        rs[i] = 1.0f / sqrtf(wave_sum(ss) * (1.0f / 2048.0f) + EPS); }
#pragma unroll
    for (int i = 0; i < 4; ++i) { u32x2* o = (u32x2*)((bf16_t*)(P.ws + OFF_H) + (size_t)(rw + i) * 2048) + lane;
#pragma unroll
        for (int j = 0; j < 8; ++j) { const f32x4 x = (f32x4){bflo(xq[i][j].x), bfhi(xq[i][j].x), bflo(xq[i][j].y), bfhi(xq[i][j].y)};
            const f32x4 y = x * rs[i] * wq[j] + sq[j]; u32x2 w; w.x = cvt_pk(y[0], y[1]); w.y = cvt_pk(y[2], y[3]); o[64 * j] = w; } }
}

DI void filter_phase(LAS unsigned char* lds, const Params& P, const int tid) {
    const int lane = tid & 63, wave = __builtin_amdgcn_readfirstlane(tid >> 6);
    const int gw = blockIdx.x * NWAVES + wave, NGW = gridDim.x * NWAVES;
    const float MIND = -3.0701134573253945f, MAXD = -15.350567286626973f;
    const float* wout = P.in[I_FWOUT];
    LAS float* tile = (LAS float*)(lds + wave * 16896);
    for (int item = gw; item < 10240; item += NGW) {
        const int g = item >= 2048 ? 1 : 0; const int local = g ? item - 2048 : item;
        const int tile_i = local >> 9, chunk = local & 511; const int L = g ? 1024 : 256; const int pos = tile_i * 64 + lane;
        const int col0 = __builtin_amdgcn_readfirstlane(chunk * 16), od = col0 >> 11, c0 = col0 & 2047, o = od >> 1, dir = od & 1;
        const float* hp = (const float*)(P.ws + OFF_H3) + (size_t)((g ? 256 : 0) + tile_i * 64) * 64;
#pragma unroll 8
        for (int i = 0; i < 64; ++i) tile[i * 65 + lane] = hp[i * 64 + lane];
        LDS_WAIT();
        float acc[16];
#pragma unroll
        for (int k = 0; k < 16; ++k) acc[k] = 0.f;
#pragma unroll 4
        for (int i = 0; i < 64; ++i) {
            const float h = tile[lane * 65 + i];
            const float* wr_ = wout + (size_t)i * 8192 + col0;
#pragma unroll
            for (int k = 0; k < 16; ++k) acc[k] += h * wr_[k];
        }
        LDS_WAIT();
        const float tt = (float)pos / (float)L;
        bf16_t* R = (bf16_t*)(P.ws + (g ? OFF_RGS : OFF_RGP));
        const int x = dir == 0 ? (L - 1 - pos) : (pos == 0 ? 2 * L - 1 : L - 1 + pos);
#pragma unroll
        for (int k = 0; k < 16; ++k) {
            const int c = c0 + k; const float delta = fabsf(MIND + (float)c * ((MAXD - MIND) / 2047.0f));
            float val = acc[k] * __expf(-tt * delta);
            if (dir == 0) { if (pos == 0) val += P.in[I_FSKIP][o * 2048 + c]; } else { if (pos == 0) val = 0.f; }
            R[((size_t)(o * 2048 + c)) * (2 * L) + x] = (bf16_t)f2bf(val);
        }
    }
}

DI void conv_core(LAS unsigned char* Fb, LAS unsigned char* Ub, int g, int j, int lane, f32x16& acc) {
    const int L = g ? 1024 : 256, nblk = L >> 5, FS = 2 * L + 16, US = L + 8;
    const int n = lane & 31, hh = lane >> 5; const int ng = 32 * j + n;
    const int a = g ? (ng >> 2) : (ng >> 4), bt = g ? (ng & 3) : (ng & 15);
    const int a_lo = g ? 8 * j : 2 * j, a_hi = g ? 8 * j + 7 : 2 * j + 1;
#pragma unroll
    for (int e = 0; e < 16; ++e) acc[e] = 0.f;
    for (int d = a_lo - (nblk - 1); d <= a_hi; ++d) {
        const int ap = a - d; const bool valid = (ap >= 0) && (ap < nblk); const int apc = valid ? ap : 0;
#pragma unroll
        for (int ks = 0; ks < 2; ++ks) {
            const int x0 = (L - 1) - (32 * d + n - 16 * ks - 8 * hh);
            const int q = x0 & 7, y = x0 - q;
            const u32x4 av = *(const LAS u32x4*)(Fb + (size_t)((q * FS + y) * 2));
            u32x4 bv = *(const LAS u32x4*)(Ub + (size_t)((bt * US + 32 * apc + 16 * ks + 8 * hh) * 2));
            if (!valid) bv = (u32x4){0u, 0u, 0u, 0u};
            acc = __builtin_amdgcn_mfma_f32_32x32x16_bf16(__builtin_bit_cast(bf16x8, av), __builtin_bit_cast(bf16x8, bv), acc, 0, 0, 0);
        }
    }
}

struct CReg { u32x4 pv[6]; unsigned lr[6]; u32x4 fa[2]; u32x4 fb[2]; };
DI void conv_load(const Params& P, int it, int ch, int tl, CReg& R) {
    const int g = (it >> 8) & 1; const int cpair = (it & 255) | ((it >> 9) << 8); const int c = 2 * cpair + ch;
    const int L = g ? 1024 : 256; const int tokbase = g * 4096;
    const bf16_t* projT = (const bf16_t*)(P.ws + OFF_PROJT);
#pragma unroll
    for (int sec = 0; sec < 3; ++sec) {
        const bf16_t* row = projT + (size_t)(sec * 2048 + c) * 8192 + tokbase;
#pragma unroll
        for (int rep = 0; rep < 2; ++rep) {
            const int tok0 = (tl + rep * 256) * 8; const int t0 = tok0 & (L - 1);
            R.pv[sec * 2 + rep] = __builtin_nontemporal_load((const u32x4*)(row + tok0));
            const unsigned left = (t0 == 0) ? 0u : (unsigned)row[tok0 - 1];
            const unsigned right = (t0 + 8 == L) ? 0u : (unsigned)row[tok0 + 8];
            R.lr[sec * 2 + rep] = left | (right << 16);
        }
    }
#pragma unroll
    for (int o = 0; o < 2; ++o) {
        const bf16_t* Rg = (const bf16_t*)(P.ws + (g ? OFF_RGS : OFF_RGP)) + (size_t)(o * 2048 + c) * (2 * L);
        u32x4 a = (u32x4){0u, 0u, 0u, 0u}, b = (u32x4){0u, 0u, 0u, 0u};
        if (8 * tl < 2 * L) { a = __builtin_nontemporal_load((const u32x4*)(Rg + 8 * tl)); if (8 * tl + 8 < 2 * L) b = __builtin_nontemporal_load((const u32x4*)(Rg + 8 * tl + 8)); }
        R.fa[o] = a; R.fb[o] = b;
    }
}
DI void conv_store(const Params& P, int it, int ch, int tl, const CReg& R, LAS unsigned char* Uv, LAS unsigned char* X1, LAS unsigned char* X2) {
    const int g = (it >> 8) & 1; const int cpair = (it & 255) | ((it >> 9) << 8); const int c = 2 * cpair + ch;
    const int L = g ? 1024 : 256, lgL = g ? 10 : 8, US = L + 8;
#pragma unroll
    for (int sec = 0; sec < 3; ++sec) {
        const int cc = sec * 2048 + c;
        const float w0 = P.in[I_HYCW][cc], w1 = P.in[I_HYCW][6144 + cc], w2 = P.in[I_HYCW][12288 + cc], bb = P.in[I_HYCB][cc];
        LAS unsigned char* dst = sec == 0 ? Uv : (sec == 1 ? X1 : X2);
#pragma unroll
        for (int rep = 0; rep < 2; ++rep) {
            const int tok0 = (tl + rep * 256) * 8; const int t0 = tok0 & (L - 1), bt = tok0 >> lgL;
            const u32x4 pv = R.pv[sec * 2 + rep]; const unsigned lr = R.lr[sec * 2 + rep];
            float f[10]; f[0] = bflo(lr); f[1] = bflo(pv.x); f[2] = bfhi(pv.x); f[3] = bflo(pv.y); f[4] = bfhi(pv.y); f[5] = bflo(pv.z); f[6] = bfhi(pv.z); f[7] = bflo(pv.w); f[8] = bfhi(pv.w); f[9] = bfhi(lr);
            float o8[8];
#pragma unroll
            for (int e = 0; e < 8; ++e) o8[e] = w0 * f[e] + w1 * f[e + 1] + w2 * f[e + 2] + bb;
            u32x4 w; w.x = cvt_pk(o8[0], o8[1]); w.y = cvt_pk(o8[2], o8[3]); w.z = cvt_pk(o8[4], o8[5]); w.w = cvt_pk(o8[6], o8[7]);
            *(LAS u32x4*)(dst + (size_t)((bt * US + t0) * 2)) = w;
        }
    }
}
DI void conv_store_filter(int L, int tl, const u32x4 fa, const u32x4 fb, LAS unsigned char* Fb) {
    const int FS = 2 * L + 16;
    if (8 * tl < 2 * L) {
        const unsigned Dw[8] = {fa.x, fa.y, fa.z, fa.w, fb.x, fb.y, fb.z, fb.w};
#pragma unroll
        for (int m = 0; m < 4; ++m) {
            u32x4 we = (u32x4){Dw[m], Dw[m + 1], Dw[m + 2], Dw[m + 3]};
            u32x4 wo; wo.x = __builtin_amdgcn_alignbit(Dw[m + 1], Dw[m], 16); wo.y = __builtin_amdgcn_alignbit(Dw[m + 2], Dw[m + 1], 16);
            wo.z = __builtin_amdgcn_alignbit(Dw[m + 3], Dw[m + 2], 16); wo.w = __builtin_amdgcn_alignbit(Dw[m + 4], Dw[m + 3], 16);
            *(LAS u32x4*)(Fb + (size_t)(((2 * m) * FS + 8 * tl) * 2)) = we;
            *(LAS u32x4*)(Fb + (size_t)(((2 * m + 1) * FS + 8 * tl) * 2)) = wo;
        }
    }
}

DI void conv_phase(LAS unsigned char* lds, const Params& P, const int tid) {
    const int wid = __builtin_amdgcn_readfirstlane(tid >> 6), lane = tid & 63, ch = wid >> 2, j = wid & 3, tl = tid & 255;
    constexpr int CH_BYTES = 68608, F_BYTES = 33280, A_BYTES = 8704;
    LAS unsigned char* base = lds + ch * CH_BYTES;
    LAS unsigned char* Fb = base; LAS unsigned char* Uv = base + F_BYTES; LAS unsigned char* X1 = Uv + A_BYTES; LAS unsigned char* X2 = X1 + A_BYTES; LAS unsigned char* Zb = X2 + A_BYTES;
    bf16_t* z2T = (bf16_t*)(P.ws + OFF_Z2T);
    const int G = gridDim.x;
    CReg R;
    if ((int)blockIdx.x < 2048) conv_load(P, blockIdx.x, ch, tl, R);
    for (int it = blockIdx.x; it < 2048; it += G) {
        const int g = (it >> 8) & 1; const int cpair = (it & 255) | ((it >> 9) << 8); const int c = 2 * cpair + ch;
        const int L = g ? 1024 : 256, US = L + 8; const int tokbase = g * 4096;
        conv_store(P, it, ch, tl, R, Uv, X1, X2);
        conv_store_filter(L, tl, R.fa[0], R.fb[0], Fb);
        __syncthreads();
        const int n = lane & 31, hh = lane >> 5; const int ng = 32 * j + n;
        const int a = g ? (ng >> 2) : (ng >> 4), bt = g ? (ng & 3) : (ng & 15);
        f32x16 acc;
        conv_core(Fb, Uv, g, j, lane, acc);
#pragma unroll
        for (int rg = 0; rg < 4; ++rg) {
            const int t0 = 32 * a + 8 * rg + 4 * hh; const int idx = bt * US + t0;
            const u32x2 xv = *(const LAS u32x2*)(X1 + (size_t)(idx * 2));
            u32x2 w; w.x = cvt_pk(bflo(xv.x) * acc[4 * rg + 0], bfhi(xv.x) * acc[4 * rg + 1]); w.y = cvt_pk(bflo(xv.y) * acc[4 * rg + 2], bfhi(xv.y) * acc[4 * rg + 3]);
            *(LAS u32x2*)(Zb + (size_t)(idx * 2)) = w;
        }
        __syncthreads();
        conv_store_filter(L, tl, R.fa[1], R.fb[1], Fb);
        __syncthreads();
        if (it + G < 2048) conv_load(P, it + G, ch, tl, R);
        conv_core(Fb, Zb, g, j, lane, acc);
#pragma unroll
        for (int rg = 0; rg < 4; ++rg) {
            const int t0 = 32 * a + 8 * rg + 4 * hh; const int idx = bt * US + t0;
            const u32x2 xv = *(const LAS u32x2*)(X2 + (size_t)(idx * 2));
            u32x2 w; w.x = cvt_pk(bflo(xv.x) * acc[4 * rg + 0], bfhi(xv.x) * acc[4 * rg + 1]); w.y = cvt_pk(bflo(xv.y) * acc[4 * rg + 2], bfhi(xv.y) * acc[4 * rg + 3]);
            *(u32x2*)(z2T + (size_t)c * 8192 + tokbase + bt * L + t0) = w;
        }
        __syncthreads();
    }
}

DI void transpose_phase(LAS unsigned char* lds, const Params& P, const int tid) {
    const int lane = tid & 63, wave = __builtin_amdgcn_readfirstlane(tid >> 6);
    const int gw = blockIdx.x * NWAVES + wave, NGW = gridDim.x * NWAVES;
    LAS bf16_t* tile = (LAS bf16_t*)(lds + wave * 16384);
    const bf16_t* src = (const bf16_t*)(P.ws + OFF_Z2T); bf16_t* dst = (bf16_t*)(P.ws + OFF_Z2);
    for (int item = gw; item < 4096; item += NGW) {
        const int tokt = item >> 5, ct = item & 31; const int tok0 = tokt * 64, c0 = ct * 64;
#pragma unroll
        for (int rr = 0; rr < 16; ++rr) { const int row = rr * 4 + (lane >> 4), cc = lane & 15;
            const u32x2 v = __builtin_nontemporal_load((const u32x2*)(src + (size_t)(c0 + row) * 8192 + tok0 + 4 * cc));
            *(LAS u32x2*)(tile + row * 68 + 4 * cc) = v; }
        LDS_WAIT();
#pragma unroll
        for (int cch = 0; cch < 8; ++cch) {
            unsigned h[8];
#pragma unroll
            for (int e = 0; e < 8; ++e) h[e] = tile[(8 * cch + e) * 68 + lane];
            u32x4 w; w.x = h[0] | (h[1] << 16); w.y = h[2] | (h[3] << 16); w.z = h[4] | (h[5] << 16); w.w = h[6] | (h[7] << 16);
            *(u32x4*)(dst + (size_t)(tok0 + lane) * 2048 + c0 + 8 * cch) = w;
        }
        LDS_WAIT();
    }
}

DI void gate_phase(const Params& P, const int tid) {
    const int lane = tid & 63, wave = tid >> 6;
    const int gw = blockIdx.x * NWAVES + wave, NGW = gridDim.x * NWAVES;
    const bf16_t* Y = (const bf16_t*)(P.ws + OFF_Y); const bf16_t* G = (const bf16_t*)(P.ws + OFF_G); bf16_t* A2 = (bf16_t*)(P.ws + OFF_A2);
    for (int row = gw; row < NTOK; row += NGW) {
        u32x4 yq[8], gq[8];
#pragma unroll
        for (int h = 0; h < 8; ++h) { const size_t off = (size_t)row * 4096 + h * 512 + lane * 8; yq[h] = __builtin_nontemporal_load((const u32x4*)(Y + off)); gq[h] = __builtin_nontemporal_load((const u32x4*)(G + off)); }
#pragma unroll
        for (int h = 0; h < 8; ++h) {
            const size_t off = (size_t)row * 4096 + h * 512 + lane * 8;
            const u32x4 yv = yq[h], gv = gq[h];
            float y[8] = {bflo(yv.x), bfhi(yv.x), bflo(yv.y), bfhi(yv.y), bflo(yv.z), bfhi(yv.z), bflo(yv.w), bfhi(yv.w)};
            float gg[8] = {bflo(gv.x), bfhi(gv.x), bflo(gv.y), bfhi(gv.y), bflo(gv.z), bfhi(gv.z), bflo(gv.w), bfhi(gv.w)};
            float s = 0.f;
#pragma unroll
            for (int e = 0; e < 8; ++e) s += y[e];
            const float mu = wave_sum(s) * (1.0f / 512.0f);
            float q = 0.f;
#pragma unroll
            for (int e = 0; e < 8; ++e) { y[e] -= mu; q += y[e] * y[e]; }
            const float rstd = 1.0f / sqrtf(wave_sum(q) * (1.0f / 512.0f) + EPS);
            const f32x4* gn = (const f32x4*)(P.in[I_GNG] + h * 512 + lane * 8); const f32x4 n0 = gn[0], n1 = gn[1];
            float o[8];
#pragma unroll
            for (int e = 0; e < 8; ++e) o[e] = gg[e] * y[e] * rstd * (e < 4 ? n0[e & 3] : n1[e & 3]);
            u32x4 w; w.x = cvt_pk(o[0], o[1]); w.y = cvt_pk(o[2], o[3]); w.z = cvt_pk(o[4], o[5]); w.w = cvt_pk(o[6], o[7]);
            *(u32x4*)(A2 + off) = w;
        }
    }
}

__global__ void __launch_bounds__(512, 2) mega_fwd(Params P) {
    extern __shared__ __attribute__((aligned(16))) unsigned char lds_raw[];
    LAS unsigned char* lds = (LAS unsigned char*)lds_raw;
    cg::grid_group grid = cg::this_grid();
    const int wv0 = __builtin_amdgcn_readfirstlane(threadIdx.x >> 6);
    volatile LAS unsigned* st = (volatile LAS unsigned*)(lds + LDS_BYTES - 16);
    if (threadIdx.x < 4) st[threadIdx.x] = 0u;
    __syncthreads();
    const XcdBarrier xbar = xcd_barrier_post((unsigned*)(P.ws + OFF_BAR), st);
    const bool fusedn = (gridDim.x == 256);
    for (int ph = P.ph_lo; ph < P.ph_hi; ++ph) {
        if (fusedn && (ph == g8::PH_N1 || ph == g8::PH_N2 || ph == g8::PH_N3)) continue;
        if (ph > P.ph_lo) { if (ph == P.ph_lo + 1) grid.sync(); else xcd_barrier(xbar); for (int i = 0; i < P.extrasync; ++i) xcd_barrier(xbar); }
        const int nrep = ((P.dupmask >> ph) & 1) ? 2 : 1;
        for (int rep = 0; rep < nrep; ++rep) {
        if (rep) xcd_barrier(xbar);
        int tid = wv0 * 64 + (int)__builtin_amdgcn_mbcnt_hi(~0u, __builtin_amdgcn_mbcnt_lo(~0u, 0u)); asm volatile("" : "+v"(tid));
        switch (ph) {
        case g8::PH_P0: p0_phase(lds, P, tid, rep); break;
        case g8::PH_P1: norm_phase(P, 0, tid); filter_phase(lds, P, tid); break;
        case g8::PH_CONV: conv_phase(lds, P, tid); break;
        case g8::PH_TR: transpose_phase(lds, P, tid); break;
        case g8::PH_N1: norm_phase(P, 1, tid); break;
        case g8::PH_N2: norm_phase(P, 2, tid); break;
        case g8::PH_N3: norm_phase(P, 3, tid); break;
        case g8::PH_FIN: norm_phase(P, 4, tid); break;
        case g8::PH_GATE: gate_phase(P, tid); break;
        default: g8::gemm_phase(lds, P, ph, tid, rep);
            if (fusedn && rep == 0) { if (ph == g8::PH_HYOUT) panel_norm(P, 1, tid); else if (ph == g8::PH_MLP2A) panel_norm(P, 2, tid); else if (ph == g8::PH_WO) panel_norm(P, 3, tid); }
            break;
        }
        }
    }
}

extern "C" void kernel_launch(void* const* d_in, const int* in_sizes, int n_in, void* d_out, int out_size, void* d_ws, size_t ws_size, hipStream_t stream) {
    static int grid_blocks = 0;
    if (grid_blocks == 0) {
        if (n_in != N_IN || ws_size < WS_NEED) { fprintf(stderr, "kernel_launch: unexpected inputs (n_in %d, ws %zu)\n", n_in, ws_size); grid_blocks = -1; return; }
        int dev = 0, cus = 0, per_cu = 0;
        hipGetDevice(&dev);
        hipDeviceGetAttribute(&cus, hipDeviceAttributeMultiprocessorCount, dev);
        if (hipFuncSetAttribute((const void*)mega_fwd, hipFuncAttributeMaxDynamicSharedMemorySize, LDS_BYTES) != hipSuccess) { fprintf(stderr, "kernel_launch: hipFuncSetAttribute failed\n"); grid_blocks = -1; return; }
        if (hipOccupancyMaxActiveBlocksPerMultiprocessor(&per_cu, (const void*)mega_fwd, NWAVES * 64, LDS_BYTES) != hipSuccess || per_cu < 1) { fprintf(stderr, "kernel_launch: occupancy query failed (%d)\n", per_cu); grid_blocks = -1; return; }
        grid_blocks = cus * per_cu;
    }
    if (grid_blocks < 0) return;
    (void)hipMemsetAsync((char*)d_ws + OFF_MOD, 0, CTL_ZERO_BYTES, stream);
    Params p{};
    for (int i = 0; i < 30; ++i) p.in[i] = (const float*)d_in[i];
    p.out = (float*)d_out; p.ws = (unsigned char*)d_ws; p.ph_lo = 0; p.ph_hi = g8::NPH; p.dupmask = DUPMASK; p.extrasync = EXTRASYNC;
    void* args[] = {&p};
    hipError_t e = hipLaunchCooperativeKernel((const void*)mega_fwd, dim3(grid_blocks), dim3(NWAVES * 64), args, LDS_BYTES, stream);
    if (e != hipSuccess) fprintf(stderr, "cooperative launch failed: %s (grid %d)\n", hipGetErrorString(e), grid_blocks);
}
```

```cpp
#include <hip/hip_runtime.h>
#include <hip/hip_cooperative_groups.h>
#include <cstdio>
#include <cstdint>
namespace cg = cooperative_groups;

#define LAS __attribute__((address_space(3)))
#define DI __device__ __forceinline__
typedef unsigned short bf16_t;
typedef short bf16x8 __attribute__((ext_vector_type(8)));
typedef float f32x4 __attribute__((ext_vector_type(4)));
typedef float f32x16 __attribute__((ext_vector_type(16)));
typedef unsigned u32x4 __attribute__((ext_vector_type(4)));
typedef unsigned u32x2 __attribute__((ext_vector_type(2)));

constexpr int D = 2048, NTOK = 8192, NPT = 4096, FF = 8192;
constexpr float EPS = 1e-6f;
constexpr int NWAVES = 8;
constexpr int LDS_BYTES = 147456;
#ifndef DUPMASK
#define DUPMASK 0
#endif
#ifndef EXTRASYNC
#define EXTRASYNC 0
#endif

constexpr size_t MiB = 1u << 20;
constexpr size_t OFF_MOD = 0, MOD_BYTES = 2 * 5 * 12288 * 4;
constexpr size_t OFF_BAR = 512 * 1024, OFF_PCNT = OFF_BAR + 16384, CTL_ZERO_BYTES = OFF_PCNT + 3 * 32 * 256;
constexpr size_t OFF_H3 = 1 * MiB;
constexpr size_t OFF_WIN = 2 * MiB, OFF_WHYO = 26 * MiB, OFF_WQKVG = 34 * MiB, OFF_WO = 82 * MiB, OFF_W1 = 98 * MiB, OFF_W2 = 162 * MiB;
constexpr size_t OFF_RGS = 226 * MiB, OFF_RGP = 242 * MiB, OFF_S0T = 246 * MiB, OFF_H = 262 * MiB, OFF_BIG = 294 * MiB;
constexpr size_t OFF_PROJT = OFF_BIG, OFF_Z2T = OFF_BIG + 96 * MiB, OFF_Z2 = OFF_BIG + 128 * MiB;
constexpr size_t OFF_U = OFF_BIG;
constexpr size_t OFF_QK = OFF_BIG, OFF_G = OFF_BIG + 64 * MiB, OFF_VT = OFF_BIG + 128 * MiB, OFF_KTF = OFF_BIG + 192 * MiB, OFF_KTB = OFF_BIG + 208 * MiB,
                 OFF_QFB = OFF_BIG + 224 * MiB, OFF_PS = OFF_BIG + 256 * MiB, OFF_PP = OFF_BIG + 320 * MiB, OFF_Y = OFF_BIG + 336 * MiB, OFF_END = OFF_BIG + 400 * MiB;
constexpr size_t OFF_A2 = OFF_QK;
constexpr size_t OFF_X = OFF_END, WS_NEED = OFF_END + 32 * MiB;

enum { I_XP = 0, I_XS, I_STATE, I_C, I_CCTX, I_WADA, I_BADA, I_NORMG, I_FINALG, I_HYWIN, I_HYBIN, I_HYCW, I_HYCB, I_FW1, I_FB1, I_FW2, I_FB2, I_FW3, I_FB3,
       I_FFREQ, I_FWOUT, I_FSKIP, I_HYWOUT, I_HYBOUT, I_WQKVG, I_DECAY, I_GNG, I_WO, I_MW1, I_MW2, N_IN };

struct Params { const float* in[30]; float* out; unsigned char* ws; int ph_lo, ph_hi, dupmask, extrasync; };

#define LDS_WAIT() asm volatile("s_waitcnt lgkmcnt(0)" ::: "memory")
DI unsigned f2bf(float f) { unsigned u = __builtin_bit_cast(unsigned, f); return (u + 0x7fffu + ((u >> 16) & 1u)) >> 16; }
DI unsigned pk2(float lo, float hi) { return f2bf(lo) | (f2bf(hi) << 16); }
DI unsigned cvt_pk(float lo, float hi) { unsigned r; asm volatile("v_cvt_pk_bf16_f32 %0, %1, %2" : "=v"(r) : "v"(lo), "v"(hi)); return r; }
DI float bflo(unsigned w) { return __builtin_bit_cast(float, w << 16); }
DI float bfhi(unsigned w) { return __builtin_bit_cast(float, w & 0xffff0000u); }
DI float bf2f(bf16_t h) { return __builtin_bit_cast(float, ((unsigned)h) << 16); }
DI float wave_sum(float v) {
#pragma unroll
    for (int o = 1; o < 64; o <<= 1) v += __shfl_xor(v, o);
    return v;
}
DI float sin_rev(float rev) { rev = rev - floorf(rev); return __builtin_amdgcn_sinf(rev); }
DI float cos_rev(float rev) { rev = rev - floorf(rev); return __builtin_amdgcn_cosf(rev); }
DI float sin_rad(float x) { return sin_rev(x * 0.15915494309189535f); }
DI float silu_f(float x) { return x / (1.0f + __expf(-x)); }
DI float silu_fast(float x) { return x * __builtin_amdgcn_rcpf(1.0f + __builtin_amdgcn_exp2f(-1.4426950408889634f * x)); }
DI float log2_sigmoid(float logit) { const float e = __expf(-logit); const float l1p = e * (1.0f - e * (0.5f - e * (0.33333333f - 0.25f * e))); return -l1p * 1.4426950408889634f; }
DI u32x4 pack8(f32x4 a, f32x4 b) { u32x4 w; w.x = cvt_pk(a[0], a[1]); w.y = cvt_pk(a[2], a[3]); w.z = cvt_pk(b[0], b[1]); w.w = cvt_pk(b[2], b[3]); return w; }

#define XB_TMO      128
#define XB_XCNT(j)  (256  + 64 * (j))
#define XB_XSUB(j)  (1280 + 64 * (j))
#define XB_XGEN(j)  (2304 + 64 * (j))
#define XB_TOP      3328
#define XB_TOPGEN   3392
#define XCD_BAR_WORDS 3456
#define XB_SPIN_CAP (1u << 18)

__device__ __forceinline__ unsigned xb_ld(unsigned* p)              { return __hip_atomic_load(p, __ATOMIC_RELAXED, __HIP_MEMORY_SCOPE_AGENT); }
__device__ __forceinline__ unsigned xb_add(unsigned* p, unsigned v) { return __hip_atomic_fetch_add(p, v, __ATOMIC_RELAXED, __HIP_MEMORY_SCOPE_AGENT); }
__device__ __forceinline__ unsigned xb_xcc_id() { return (unsigned)__builtin_amdgcn_s_getreg((3 << 11) | 20) & 0xFu; }
#define XB_SPIN(cond, bar) do { unsigned _sp = 0; while (cond) { __builtin_amdgcn_s_sleep(1); \
    if ((++_sp & 255u) == 0u) { if (xb_ld(&(bar)[XB_TMO])) break; if (_sp > XB_SPIN_CAP) { atomicAdd(&(bar)[XB_TMO], 1u); break; } } } } while (0)

struct XcdBarrier {
    unsigned* bar; unsigned x;
    volatile LAS unsigned* st;
};

__device__ __forceinline__ XcdBarrier xcd_barrier_post(unsigned* bar, volatile LAS unsigned* st) {
    XcdBarrier b; b.bar = bar; b.x = xb_xcc_id(); b.st = st;
    if (threadIdx.x == 0) (void)xb_add(&bar[XB_XCNT(b.x)], 1u);
    return b;
}
__device__ __forceinline__ void xcd_barrier_complete(unsigned* bar, unsigned x, unsigned& nloc, unsigned& nx) {
    const unsigned G = gridDim.x * gridDim.y * gridDim.z;
    unsigned sum, cnt, mine, sp = 0u;
    for (;;) {
        sum = 0u; cnt = 0u; mine = 0u;
#pragma unroll
        for (unsigned j = 0; j < 16; ++j) { const unsigned c = xb_ld(&bar[XB_XCNT(j)]); sum += c; cnt += (c > 0u) ? 1u : 0u; mine = (j == x) ? c : mine; }
        if (sum == G) break;
        __builtin_amdgcn_s_sleep(1);
        if ((++sp & 255u) == 0u) { if (xb_ld(&bar[XB_TMO])) break; if (sp > XB_SPIN_CAP) { atomicAdd(&bar[XB_TMO], 1u); break; } }
    }
    nloc = mine > 0u ? mine : 1u; nx = cnt > 0u ? cnt : 1u;
}

__device__ __forceinline__ void xcd_barrier(const XcdBarrier& b) {
    asm volatile("s_waitcnt vmcnt(0)" ::: "memory");
    __syncthreads();
    if (threadIdx.x == 0) {
        unsigned* bar = b.bar;
        __builtin_amdgcn_s_waitcnt(0);
        unsigned nloc = b.st[0], nx = b.st[1];
        if (nloc == 0u) { xcd_barrier_complete(bar, b.x, nloc, nx); b.st[0] = nloc; b.st[1] = nx; }
        const unsigned old = xb_add(&bar[XB_XSUB(b.x)], 1u);
        const unsigned gen = old / nloc;
        if (old + 1u == (gen + 1u) * nloc) {
            __builtin_amdgcn_fence(__ATOMIC_RELEASE, "agent");
            asm volatile("s_waitcnt vmcnt(0)" ::: "memory");
            const unsigned og = xb_add(&bar[XB_TOP], 1u);
            const unsigned tg = og / nx;
            if (og + 1u == (tg + 1u) * nx) xb_add(&bar[XB_TOPGEN], 1u);
            else XB_SPIN(xb_ld(&bar[XB_TOPGEN]) == tg, bar);
            __builtin_amdgcn_fence(__ATOMIC_ACQUIRE, "agent");
            xb_add(&bar[XB_XGEN(b.x)], 1u);
            asm volatile("s_waitcnt vmcnt(0)" ::: "memory");
        } else {
            XB_SPIN(xb_ld(&bar[XB_XGEN(b.x)]) == gen, bar);
            __builtin_amdgcn_fence(__ATOMIC_ACQUIRE, "agent");
            asm volatile("s_waitcnt vmcnt(0)" ::: "memory");
        }
    }
    __syncthreads();
}


namespace g8 {
constexpr int BK = 64, HALF = 128, HTB = HALF * BK * 2;
DI int lds_byte(int r, int c) { const int st = (r >> 4) * 2 + (c >> 5), rr = r & 15, cc = c & 31, ob = rr * 64 + cc * 2; return st * 1024 + (ob ^ (((ob >> 9) & 1) << 5)); }
DI void stage_rc(int b, int& R, int& C) { const int st = b / 1024, sb = b % 1024, swz = sb ^ (((sb >> 9) & 1) << 5); R = (st >> 1) * 16 + swz / 64; C = (st & 1) * 32 + (swz % 64) / 2; }
DI int perm32(int rho) { const int n = rho >> 4, i = rho & 15; return 8 * (i >> 2) + 4 * n + (i & 3); }

enum { EP_PLAIN = 0, EP_PROJ, EP_RELU2, EP_SILU, EP_ADD, EP_F32, EP_RES0, EP_RES, EP_QK, EP_KT, EP_S };
enum { PH_P0 = 0, PH_P1, PH_PROJ, PH_CONV, PH_TR, PH_HYOUT, PH_N1, PH_MLP1A, PH_MLP2A, PH_N2, PH_QKVG, PH_RET1, PH_RET2, PH_GATE, PH_WO, PH_N3, PH_MLP1B, PH_MLP2B, PH_FIN, NPH };

struct Unit { const char* A; const char* B; unsigned lda, ldb; int nt; int kind; int row0, col0; char* out; unsigned ldc; const float* aux; const float* aux2; int h; };

DI void remap(int nM, int nN, int L, int& pm, int& pn) {
    const int nwg = nM * nN; int wgid = L;
    { const int q = nwg / 8, r = nwg % 8, xcd = wgid % 8, off = wgid / 8; wgid = (xcd < r ? xcd * (q + 1) : r * (q + 1) + (xcd - r) * q) + off; }
    const int nig = 8 * nN, gid = wgid / nig, fm = gid * 8, gsz = (nM - fm) < 8 ? (nM - fm) : 8;
    pm = fm + ((wgid % nig) % gsz); pn = (wgid % nig) / gsz;
}

DI bool get_unit(const Params& P, int ph, int idx, Unit& u) {
    unsigned char* ws = P.ws;
    float* mod = (float*)(ws + OFF_MOD);
    u.aux = nullptr; u.aux2 = nullptr; u.h = 0;
    int pm, pn;
    switch (ph) {
    case PH_PROJ: {
        if (idx >= 768) return false;
        remap(24, 32, idx, pm, pn);
        u.A = (const char*)(ws + OFF_WIN) + (size_t)pm * 256 * 2048 * 2; u.lda = 2048;
        u.B = (const char*)(ws + OFF_H) + (size_t)pn * 256 * 2048 * 2; u.ldb = 2048; u.nt = 32;
        u.kind = EP_PROJ; u.out = (char*)(ws + OFF_PROJT); u.ldc = 8192; u.aux = P.in[I_HYBIN]; u.row0 = 256 * pm; u.col0 = 256 * pn;
        return true; }
    case PH_HYOUT: {
        if (idx >= 256) return false;
        remap(32, 8, idx, pm, pn);
        u.A = (const char*)(ws + OFF_Z2) + (size_t)pm * 256 * 2048 * 2; u.lda = 2048;
        u.B = (const char*)(ws + OFF_WHYO) + (size_t)pn * 256 * 2048 * 2; u.ldb = 2048; u.nt = 32;
        u.kind = EP_RES0; u.out = (char*)P.out; u.ldc = 2048; u.aux = mod + 4096; u.aux2 = P.in[I_HYBOUT]; u.row0 = 256 * pm; u.col0 = 256 * pn;
        return true; }
    case PH_MLP1A: case PH_MLP1B: {
        if (idx >= 1024) return false;
        const int l = (ph == PH_MLP1B) ? 1 : 0;
        remap(32, 32, idx, pm, pn);
        u.A = (const char*)(ws + OFF_H) + (size_t)pm * 256 * 2048 * 2; u.lda = 2048;
        u.B = (const char*)(ws + OFF_W1) + ((size_t)l * 8192 + (size_t)pn * 256) * 2048 * 2; u.ldb = 2048; u.nt = 32;
        u.kind = EP_RELU2; u.out = (char*)(ws + OFF_U); u.ldc = 8192; u.row0 = 256 * pm; u.col0 = 256 * pn;
        return true; }
    case PH_MLP2A: case PH_MLP2B: {
        if (idx >= 256) return false;
        const int l = (ph == PH_MLP2B) ? 1 : 0;
        remap(32, 8, idx, pm, pn);
        u.A = (const char*)(ws + OFF_U) + (size_t)pm * 256 * 8192 * 2; u.lda = 8192;
        u.B = (const char*)(ws + OFF_W2) + ((size_t)l * 2048 + (size_t)pn * 256) * 8192 * 2; u.ldb = 8192; u.nt = 128;
        u.kind = EP_RES; u.out = (char*)P.out; u.ldc = 2048; u.aux = mod + l * 61440 + 10240; u.row0 = 256 * pm; u.col0 = 256 * pn;
        return true; }
    case PH_WO: {
        if (idx >= 256) return false;
        remap(32, 8, idx, pm, pn);
        u.A = (const char*)(ws + OFF_A2) + (size_t)pm * 256 * 4096 * 2; u.lda = 4096;
        u.B = (const char*)(ws + OFF_WO) + (size_t)pn * 256 * 4096 * 2; u.ldb = 4096; u.nt = 64;
        u.kind = EP_RES; u.out = (char*)P.out; u.ldc = 2048; u.aux = mod + 61440 + 4096; u.row0 = 256 * pm; u.col0 = 256 * pn;
        return true; }
    case PH_QKVG: {
        if (idx >= 1024) return false;
        const char* Hb = (const char*)(ws + OFF_H); const char* Wq = (const char*)(ws + OFF_WQKVG);
        u.lda = 2048; u.ldb = 2048; u.nt = 32;
        if (idx < 512) { remap(32, 16, idx, pm, pn); if (idx >= 256) pm ^= 16;
            u.A = Hb + (size_t)pm * 256 * 2048 * 2; u.B = Wq + (size_t)pn * 256 * 2048 * 2;
            u.kind = EP_QK; u.out = (char*)(ws + OFF_QK); u.ldc = 4096; u.h = pn & 7;
        } else { remap(16, 32, idx - 512, pm, pn);
            u.A = Wq + (size_t)(4096 + pm * 256) * 2048 * 2; u.B = Hb + (size_t)pn * 256 * 2048 * 2;
            u.kind = EP_PLAIN; u.out = (char*)(ws + OFF_VT); u.ldc = 8192;
        }
        u.row0 = 256 * pm; u.col0 = 256 * pn;
        return true; }
    case PH_RET1: {
        int kt = -1, us = -1;
        if (gridDim.x == 256) {
            if (idx >= 1280) return false;
            const int c = idx & 255, i = idx >> 8;
            if (c < 128) { if (i == 0) kt = c; else if (i <= 2) us = (i - 1) * 128 + c; else return false; }
            else us = 256 + 128 * i + (c - 128);
        } else { if (idx >= 1024) return false; if (idx < 128) kt = idx; else us = idx - 128; }
        const char* QK = (const char*)(ws + OFF_QK);
        if (kt >= 0) {
            remap(8, 16, kt, pm, pn);
            u.A = (const char*)(ws + OFF_WQKVG) + (size_t)(2048 + pm * 256) * 2048 * 2; u.lda = 2048;
            u.B = (const char*)(ws + OFF_H) + (size_t)pn * 256 * 2048 * 2; u.ldb = 2048; u.nt = 32;
            u.kind = EP_KT; u.out = (char*)(ws + OFF_KTF); u.aux = (const float*)(ws + OFF_KTB); u.ldc = 4096; u.h = pm;
        } else if (us < 512) {
            const int bi = us >> 4, rest = us & 15; pm = rest >> 2; pn = rest & 3; const int b = bi >> 3, h = bi & 7; const size_t tok0 = 4096 + (size_t)b * 1024;
            u.A = QK + ((tok0 + 256 * pm) * 4096 + h * 256) * 2; u.lda = 4096;
            u.B = QK + ((tok0 + 256 * pn) * 4096 + 2048 + h * 256) * 2; u.ldb = 4096; u.nt = 4;
            u.kind = EP_S; u.out = (char*)(ws + OFF_PS) + (size_t)bi * 1024 * 1024 * 2; u.ldc = 1024; u.h = h;
        } else if (us < 768) {
            const int l = us - 512, bi = l >> 3, rest = l & 7; pm = rest >> 1; pn = rest & 1; const int b = bi >> 3, h = bi & 7;
            u.A = (const char*)(ws + OFF_QFB) + (((size_t)b * 1024 + 256 * pm) * 4096 + h * 512) * 2; u.lda = 4096;
            u.B = (const char*)(ws + OFF_S0T) + ((size_t)bi * 512 + 256 * pn) * 512 * 2; u.ldb = 512; u.nt = 8;
            u.kind = EP_PLAIN; u.out = (char*)(ws + OFF_Y) + ((4096 + (size_t)b * 1024) * 4096 + h * 512) * 2; u.ldc = 4096;
        } else {
            const int bi = us - 768; pm = 0; pn = 0; const int b = bi >> 3, h = bi & 7; const size_t tok0 = (size_t)b * 256;
            u.A = QK + (tok0 * 4096 + h * 256) * 2; u.lda = 4096;
            u.B = QK + (tok0 * 4096 + 2048 + h * 256) * 2; u.ldb = 4096; u.nt = 4;
            u.kind = EP_S; u.out = (char*)(ws + OFF_PP) + (size_t)bi * 256 * 256 * 2; u.ldc = 256; u.h = h;
        }
        u.row0 = 256 * pm; u.col0 = 256 * pn;
        return true; }
    case PH_RET2: {
        if (idx >= 1536) return false;
        if (idx >= 1024) {
            remap(32, 16, idx - 1024, pm, pn);
            u.A = (const char*)(ws + OFF_H) + (size_t)pm * 256 * 2048 * 2; u.lda = 2048;
            u.B = (const char*)(ws + OFF_WQKVG) + (size_t)(8192 + pn * 256) * 2048 * 2; u.ldb = 2048; u.nt = 32;
            u.kind = EP_SILU; u.out = (char*)(ws + OFF_G); u.ldc = 4096;
            u.row0 = 256 * pm; u.col0 = 256 * pn;
            return true;
        }
        if (idx >= 512) {
            const int l = idx - 512, bi = l >> 1; pm = 0; pn = l & 1; const int b = bi >> 4, h = (bi >> 1) & 7, dir = bi & 1;
            u.A = (const char*)(ws + (dir ? OFF_KTB : OFF_KTF)) + ((size_t)(h * 256) * 4096 + b * 256) * 2; u.lda = 4096;
            u.B = (const char*)(ws + OFF_VT) + ((size_t)(h * 512 + 256 * pn) * 8192 + b * 256) * 2; u.ldb = 8192; u.nt = 4;
            u.kind = EP_F32; u.out = (char*)(P.out + (size_t)NTOK * D + (size_t)((b * 2 + dir) * 8 + h) * 256 * 512); u.ldc = 512;
        } else if (idx < 256) {
            const int bi = idx >> 3, rest = idx & 7; pm = rest >> 1; pn = rest & 1; const int b = bi >> 3, h = bi & 7;
            u.A = (const char*)(ws + OFF_PS) + ((size_t)bi * 1024 * 1024 + (size_t)256 * pm * 1024) * 2; u.lda = 1024;
            u.B = (const char*)(ws + OFF_VT) + ((size_t)(h * 512 + 256 * pn) * 8192 + 4096 + b * 1024) * 2; u.ldb = 8192; u.nt = 16;
            u.kind = EP_ADD; u.out = (char*)(ws + OFF_Y) + ((4096 + (size_t)b * 1024) * 4096 + h * 512) * 2; u.ldc = 4096;
        } else {
            const int l = idx - 256, bi = l >> 1; pm = 0; pn = l & 1; const int b = bi >> 3, h = bi & 7;
            u.A = (const char*)(ws + OFF_PP) + (size_t)bi * 65536 * 2; u.lda = 256;
            u.B = (const char*)(ws + OFF_VT) + ((size_t)(h * 512 + 256 * pn) * 8192 + b * 256) * 2; u.ldb = 8192; u.nt = 4;
            u.kind = EP_PLAIN; u.out = (char*)(ws + OFF_Y) + (((size_t)b * 256) * 4096 + h * 512) * 2; u.ldc = 4096;
        }
        u.row0 = 256 * pm; u.col0 = 256 * pn;
        return true; }
    default: return false;
    }
}

DI void epilogue(const Params& P, const Unit& u, const f32x4 (&acc)[2][2][4][2], int wr, int wc, int fr, int fq) {
#define EPI_BEGIN _Pragma("unroll") for (int ai = 0; ai < 2; ++ai) _Pragma("unroll") for (int m = 0; m < 4; ++m) { const int r = u.row0 + ai * 128 + wr * 64 + m * 16 + fr; \
        _Pragma("unroll") for (int bj = 0; bj < 2; ++bj) { const int c = u.col0 + bj * 128 + wc * 32 + 8 * fq; f32x4 v0 = acc[ai][bj][m][0], v1 = acc[ai][bj][m][1];
#define EPI_END } }
    switch (u.kind) {
    case EP_PLAIN: {
        EPI_BEGIN
            *(u32x4*)(u.out + ((size_t)r * u.ldc + c) * 2) = pack8(v0, v1);
        EPI_END
    } break;
    case EP_PROJ: {
        float rb[2][4];
#pragma unroll
        for (int ai = 0; ai < 2; ++ai)
#pragma unroll
            for (int m = 0; m < 4; ++m) rb[ai][m] = u.aux[u.row0 + ai * 128 + wr * 64 + m * 16 + fr];
        EPI_BEGIN
            const float b = rb[ai][m]; v0 = v0 + b; v1 = v1 + b;
            *(u32x4*)(u.out + ((size_t)r * u.ldc + c) * 2) = pack8(v0, v1);
        EPI_END
    } break;
    case EP_RELU2: {
        EPI_BEGIN
#pragma unroll
            for (int e = 0; e < 4; ++e) { float a = fmaxf(v0[e], 0.f), b = fmaxf(v1[e], 0.f); v0[e] = a * a; v1[e] = b * b; }
            *(u32x4*)(u.out + ((size_t)r * u.ldc + c) * 2) = pack8(v0, v1);
        EPI_END
    } break;
    case EP_SILU: {
        EPI_BEGIN
#pragma unroll
            for (int e = 0; e < 4; ++e) { v0[e] = silu_fast(v0[e]); v1[e] = silu_fast(v1[e]); }
            *(u32x4*)(u.out + ((size_t)r * u.ldc + c) * 2) = pack8(v0, v1);
        EPI_END
    } break;
    case EP_ADD: {
#pragma unroll
        for (int bj = 0; bj < 2; ++bj) {
            const int c = u.col0 + bj * 128 + wc * 32 + 8 * fq;
#pragma unroll
            for (int ai = 0; ai < 2; ++ai) {
                u32x4 o[4];
#pragma unroll
                for (int m = 0; m < 4; ++m) { const int r = u.row0 + ai * 128 + wr * 64 + m * 16 + fr; o[m] = *(const u32x4*)(u.out + ((size_t)r * u.ldc + c) * 2); }
#pragma unroll
                for (int m = 0; m < 4; ++m) { const int r = u.row0 + ai * 128 + wr * 64 + m * 16 + fr; f32x4 v0 = acc[ai][bj][m][0], v1 = acc[ai][bj][m][1];
                    v0[0] += bflo(o[m].x); v0[1] += bfhi(o[m].x); v0[2] += bflo(o[m].y); v0[3] += bfhi(o[m].y); v1[0] += bflo(o[m].z); v1[1] += bfhi(o[m].z); v1[2] += bflo(o[m].w); v1[3] += bfhi(o[m].w);
                    *(u32x4*)(u.out + ((size_t)r * u.ldc + c) * 2) = pack8(v0, v1); }
            }
        }
    } break;
    case EP_F32: {
        EPI_BEGIN
            f32x4* p = (f32x4*)(u.out + ((size_t)r * u.ldc + c) * 4); __builtin_nontemporal_store(v0, p); __builtin_nontemporal_store(v1, p + 1);
        EPI_END
    } break;
    case EP_RES0: case EP_RES: {
        const bool first = (u.kind == EP_RES0);
        bf16_t* xb = (bf16_t*)(P.ws + OFF_X);
        const int cond = u.row0 < NPT ? 0 : 1 + ((u.row0 - NPT) >> 10);
#pragma unroll
        for (int bj = 0; bj < 2; ++bj) {
            const int c = u.col0 + bj * 128 + wc * 32 + 8 * fq;
            const f32x4* gp = (const f32x4*)(u.aux + (size_t)cond * 12288 + c); const f32x4 g0 = gp[0], g1 = gp[1];
            f32x4 b0 = (f32x4){0.f, 0.f, 0.f, 0.f}, b1 = b0;
            if (u.aux2) { const f32x4* bp = (const f32x4*)(u.aux2 + c); b0 = bp[0] * g0; b1 = bp[1] * g1; }
#pragma unroll
            for (int ai = 0; ai < 2; ++ai) {
                f32x4 x0[4], x1[4];
                if (first) {
#pragma unroll
                    for (int m = 0; m < 4; ++m) { const int r = u.row0 + ai * 128 + wr * 64 + m * 16 + fr;
                        const f32x4* xi = (const f32x4*)((r < NPT ? P.in[I_XP] + (size_t)r * 2048 : P.in[I_XS] + (size_t)(r - NPT) * 2048) + c); x0[m] = xi[0]; x1[m] = xi[1]; }
                } else {
                    u32x4 o[4];
#pragma unroll
                    for (int m = 0; m < 4; ++m) { const int r = u.row0 + ai * 128 + wr * 64 + m * 16 + fr; o[m] = *(const u32x4*)(xb + (size_t)r * 2048 + c); }
#pragma unroll
                    for (int m = 0; m < 4; ++m) { x0[m] = (f32x4){bflo(o[m].x), bfhi(o[m].x), bflo(o[m].y), bfhi(o[m].y)}; x1[m] = (f32x4){bflo(o[m].z), bfhi(o[m].z), bflo(o[m].w), bfhi(o[m].w)}; }
                }
#pragma unroll
                for (int m = 0; m < 4; ++m) { const int r = u.row0 + ai * 128 + wr * 64 + m * 16 + fr;
                    *(u32x4*)(xb + (size_t)r * 2048 + c) = pack8(x0[m] + b0 + g0 * acc[ai][bj][m][0], x1[m] + b1 + g1 * acc[ai][bj][m][1]); }
            }
        }
    } break;
    case EP_QK: {
        const bool isk = u.col0 >= 2048; const int hd = u.h;
        const float lgf = log2_sigmoid(P.in[I_DECAY][hd]), lgb = log2_sigmoid(P.in[I_DECAY][8 + hd]);
        bf16_t* qfb = (bf16_t*)(P.ws + OFF_QFB);
        const bool samp = u.row0 >= NPT;
        float invr[2][4];
#pragma unroll
        for (int bj = 0; bj < 2; ++bj) { const int p0 = ((bj * 128 + wc * 32 + 8 * fq) & 255) >> 1;
#pragma unroll
            for (int e = 0; e < 4; ++e) invr[bj][e] = __builtin_amdgcn_exp2f(-(float)((p0 + e) & 63) * 0.20762050593046014f) * 0.15915494309189535f; }
#pragma unroll
        for (int ai = 0; ai < 2; ++ai)
#pragma unroll
            for (int m = 0; m < 4; ++m) {
                const int r = u.row0 + ai * 128 + wr * 64 + m * 16 + fr;
                const int t = (r - NPT) & 1023;
                const float prow = (float)(t >> 6), pcol = (float)(t & 63);
                const float gf = __builtin_amdgcn_exp2f(lgf * (float)(t + 1)), gb = __builtin_amdgcn_exp2f(lgb * (float)(1024 - t));
#pragma unroll
                for (int bj = 0; bj < 2; ++bj) {
                    const int c = u.col0 + bj * 128 + wc * 32 + 8 * fq; const f32x4 v0 = acc[ai][bj][m][0], v1 = acc[ai][bj][m][1];
                    float v[8] = {v0[0], v0[1], v0[2], v0[3], v1[0], v1[1], v1[2], v1[3]};
                    const int dkk = c & 255;
                    if (samp) {
                        const float posv = (dkk < 128) ? prow : pcol;
#pragma unroll
                        for (int e = 0; e < 4; ++e) { const float rev = posv * invr[bj][e]; const float sn = sin_rev(rev), cs = cos_rev(rev);
                            const float a = v[2 * e], b = v[2 * e + 1]; v[2 * e] = a * cs - b * sn; v[2 * e + 1] = a * sn + b * cs; }
                    }
                    if (isk) {
#pragma unroll
                        for (int e = 0; e < 8; ++e) v[e] *= 0.0625f;
                    }
                    u32x4 w; w.x = cvt_pk(v[0], v[1]); w.y = cvt_pk(v[2], v[3]); w.z = cvt_pk(v[4], v[5]); w.w = cvt_pk(v[6], v[7]);
                    *(u32x4*)(u.out + ((size_t)r * 4096 + c) * 2) = w;
                    if (!isk && samp) {
                        bf16_t* q0 = qfb + (size_t)(r - NPT) * 4096 + hd * 512 + dkk;
                        u32x4 wf, wb; wf.x = cvt_pk(v[0] * gf, v[1] * gf); wf.y = cvt_pk(v[2] * gf, v[3] * gf); wf.z = cvt_pk(v[4] * gf, v[5] * gf); wf.w = cvt_pk(v[6] * gf, v[7] * gf);
                        wb.x = cvt_pk(v[0] * gb, v[1] * gb); wb.y = cvt_pk(v[2] * gb, v[3] * gb); wb.z = cvt_pk(v[4] * gb, v[5] * gb); wb.w = cvt_pk(v[6] * gb, v[7] * gb);
                        *(u32x4*)q0 = wf; *(u32x4*)(q0 + 256) = wb;
                    }
                }
            }
    } break;
    case EP_KT: {
        const int hd = u.h;
        const float lgf = log2_sigmoid(P.in[I_DECAY][hd]), lgb = log2_sigmoid(P.in[I_DECAY][8 + hd]);
        char* outb = (char*)u.aux;
        EPI_BEGIN
            const int t0 = c & 255; float vf[8], vb[8];
#pragma unroll
            for (int e = 0; e < 8; ++e) { const float x = (e < 4 ? v0[e & 3] : v1[e & 3]) * 0.0625f; const int t = t0 + e;
                vf[e] = x * __builtin_amdgcn_exp2f(lgf * (float)(255 - t)); vb[e] = x * __builtin_amdgcn_exp2f(lgb * (float)t); }
            u32x4 wf, wb; wf.x = cvt_pk(vf[0], vf[1]); wf.y = cvt_pk(vf[2], vf[3]); wf.z = cvt_pk(vf[4], vf[5]); wf.w = cvt_pk(vf[6], vf[7]);
            wb.x = cvt_pk(vb[0], vb[1]); wb.y = cvt_pk(vb[2], vb[3]); wb.z = cvt_pk(vb[4], vb[5]); wb.w = cvt_pk(vb[6], vb[7]);
            *(u32x4*)(u.out + ((size_t)r * 4096 + c) * 2) = wf; *(u32x4*)(outb + ((size_t)r * 4096 + c) * 2) = wb;
        EPI_END
    } break;
    case EP_S: {
        const int hd = u.h;
        const float lgf = log2_sigmoid(P.in[I_DECAY][hd]), lgb = log2_sigmoid(P.in[I_DECAY][8 + hd]);
        EPI_BEGIN
            float v[8];
#pragma unroll
            for (int e = 0; e < 8; ++e) { const float x = (e < 4 ? v0[e & 3] : v1[e & 3]); const int dlt = r - (c + e);
                const float ar = dlt > 0 ? lgf * (float)dlt : lgb * (float)(-dlt);
                float mk = __builtin_amdgcn_exp2f(ar); mk = dlt == 0 ? 2.0f : mk; v[e] = x * mk; }
            u32x4 w; w.x = cvt_pk(v[0], v[1]); w.y = cvt_pk(v[2], v[3]); w.z = cvt_pk(v[4], v[5]); w.w = cvt_pk(v[6], v[7]);
            *(u32x4*)(u.out + ((size_t)r * u.ldc + c) * 2) = w;
        EPI_END
    } break;
    default: break;
    }
#undef EPI_BEGIN
#undef EPI_END
}

DI void gemm_phase(LAS unsigned char* lds, const Params& P, int ph, const int tid, const int rep) {
    const int wid = __builtin_amdgcn_readfirstlane(tid >> 6), lane = tid & 63, wr = wid >> 2, wc = wid & 3, fr = lane & 15, fq = lane >> 4;
    const int G = gridDim.x, bid = blockIdx.x + ((rep && ph == PH_RET2) ? 256 : 0);
    int sR0, sC0; stage_rc(tid * 16, sR0, sC0);
    const int sB0 = (sR0 & ~31) + perm32(sR0 & 31);
    const unsigned ldsw = (unsigned)wid * 1024u;
    const int aoff = lds_byte(wr * 64 + fr, fq * 8), boff = lds_byte(wc * 32 + fr, fq * 8);
#define G8_SA(b, h) (((b) * 2 + (h)) * HTB)
#define G8_SB(b, h) ((4 + (b) * 2 + (h)) * HTB)
#define G8_STAGE(bufoff, gbase, V0, V1) do { \
        __builtin_amdgcn_global_load_lds((const unsigned*)((const char*)(gbase) + (V0)), (LAS unsigned*)(lds + (bufoff) + ldsw), 16, 0, 0); \
        __builtin_amdgcn_global_load_lds((const unsigned*)((const char*)(gbase) + (V1)), (LAS unsigned*)(lds + (bufoff) + ldsw + 8192), 16, 0, 0); } while (0)
#define G8_LDA(dst, b, h) do { _Pragma("unroll") for (int m = 0; m < 4; ++m) _Pragma("unroll") for (int k = 0; k < 2; ++k) dst[m][k] = *(const LAS bf16x8*)(lds + G8_SA(b, h) + aoff + m * 2048 + k * 1024); } while (0)
#define G8_LDB(dst, b, h) do { _Pragma("unroll") for (int n = 0; n < 2; ++n) _Pragma("unroll") for (int k = 0; k < 2; ++k) dst[n][k] = *(const LAS bf16x8*)(lds + G8_SB(b, h) + boff + n * 2048 + k * 1024); } while (0)
#define G8_MMA(ai, bj, At, Bt) do { __builtin_amdgcn_s_setprio(1); _Pragma("unroll") for (int m = 0; m < 4; ++m) _Pragma("unroll") for (int n = 0; n < 2; ++n) _Pragma("unroll") for (int k = 0; k < 2; ++k) \
        acc[ai][bj][m][n] = __builtin_amdgcn_mfma_f32_16x16x32_bf16(Bt[n][k], At[m][k], acc[ai][bj][m][n], 0, 0, 0); __builtin_amdgcn_s_setprio(0); } while (0)
#define G8_WAIT_V(n) asm volatile("s_waitcnt vmcnt(" #n ")" ::: "memory")
#define G8_WAIT_L(n) asm volatile("s_waitcnt lgkmcnt(" #n ")" ::: "memory")
#define G8_BAR __builtin_amdgcn_s_barrier()
#define G8_SCHED __builtin_amdgcn_sched_barrier(0)
    int ui = 0;
    const char* cA; const char* cB; unsigned clda, cldb; int nt;
    { Unit u0; if (!get_unit(P, ph, bid, u0)) return; cA = u0.A; cB = u0.B; clda = u0.lda; cldb = u0.ldb; nt = u0.nt; }
    f32x4 acc[2][2][4][2];
#pragma unroll
    for (int a = 0; a < 2; ++a)
#pragma unroll
        for (int b = 0; b < 2; ++b)
#pragma unroll
            for (int m = 0; m < 4; ++m)
#pragma unroll
                for (int n = 0; n < 2; ++n) acc[a][b][m][n] = (f32x4){0.f, 0.f, 0.f, 0.f};
    bf16x8 At[4][2], B0[2][2], B1[2][2];
    const size_t kstep = 128;
#define VOA0(ld) ((unsigned)(sR0 * (int)(ld) + sC0) * 2u)
#define VOA1(ld) ((unsigned)((sR0 + 64) * (int)(ld) + sC0) * 2u)
#define VOB0(ld) ((unsigned)(sB0 * (int)(ld) + sC0) * 2u)
#define VOB1(ld) ((unsigned)((sB0 + 64) * (int)(ld) + sC0) * 2u)
    { const size_t chA = (size_t)HALF * clda * 2, chB = (size_t)HALF * cldb * 2;
    G8_STAGE(G8_SB(0, 0), cB, VOB0(cldb), VOB1(cldb)); G8_STAGE(G8_SB(0, 1), cB + chB, VOB0(cldb), VOB1(cldb)); G8_STAGE(G8_SA(0, 0), cA, VOA0(clda), VOA1(clda)); G8_STAGE(G8_SA(0, 1), cA + chA, VOA0(clda), VOA1(clda));
    if (wr == 1) G8_BAR;
    G8_WAIT_V(2); G8_BAR;
    G8_STAGE(G8_SB(1, 0), cB + kstep, VOB0(cldb), VOB1(cldb)); G8_STAGE(G8_SA(1, 0), cA + kstep, VOA0(clda), VOA1(clda)); G8_STAGE(G8_SB(1, 1), cB + chB + kstep, VOB0(cldb), VOB1(cldb));
    G8_WAIT_V(6); G8_BAR; }
    for (;;) {
        const char* nA; const char* nB; unsigned nlda, nldb; int nnt; bool has_next;
        { Unit un; has_next = get_unit(P, ph, bid + (ui + 1) * G, un);
          nA = has_next ? un.A : cA; nB = has_next ? un.B : cB; nlda = has_next ? un.lda : clda; nldb = has_next ? un.ldb : cldb; nnt = has_next ? un.nt : nt; }
        const size_t chA = (size_t)HALF * clda * 2;
        for (int t = 0; t < nt; t += 2) {
            const bool last = (t == nt - 2);
            const char* a1 = cA + (size_t)(t + 1) * kstep;
            const char* a2 = last ? nA : cA + (size_t)(t + 2) * kstep; const char* b2 = last ? nB : cB + (size_t)(t + 2) * kstep;
            const char* a3 = a2 + kstep; const char* b3 = b2 + kstep;
            const unsigned lda2 = last ? nlda : clda, ldb2 = last ? nldb : cldb;
            const size_t hA2 = (size_t)HALF * lda2 * 2, hB2 = (size_t)HALF * ldb2 * 2;
            G8_LDB(B0, 0, 0); G8_LDB(B1, 0, 1); G8_SCHED; G8_LDA(At, 0, 0); G8_STAGE(G8_SA(1, 1), a1 + chA, VOA0(clda), VOA1(clda));
            G8_WAIT_V(8); G8_WAIT_L(0); G8_BAR; G8_MMA(0, 0, At, B0); G8_MMA(0, 1, At, B1); G8_BAR; G8_SCHED;
            G8_LDA(At, 0, 1); G8_STAGE(G8_SB(0, 0), b2, VOB0(ldb2), VOB1(ldb2)); G8_STAGE(G8_SB(0, 1), b2 + hB2, VOB0(ldb2), VOB1(ldb2)); G8_STAGE(G8_SA(0, 0), a2, VOA0(lda2), VOA1(lda2));
            G8_WAIT_V(8); G8_WAIT_L(0); G8_BAR; G8_MMA(1, 0, At, B0); G8_MMA(1, 1, At, B1); G8_BAR; G8_SCHED;
            G8_LDB(B0, 1, 0); G8_LDB(B1, 1, 1); G8_SCHED; G8_LDA(At, 1, 0); G8_STAGE(G8_SA(0, 1), a2 + hA2, VOA0(lda2), VOA1(lda2));
            G8_WAIT_V(8); G8_WAIT_L(0); G8_BAR; G8_MMA(0, 0, At, B0); G8_MMA(0, 1, At, B1); G8_BAR; G8_SCHED;
            G8_LDA(At, 1, 1); G8_STAGE(G8_SB(1, 0), b3, VOB0(ldb2), VOB1(ldb2)); G8_STAGE(G8_SB(1, 1), b3 + hB2, VOB0(ldb2), VOB1(ldb2)); G8_STAGE(G8_SA(1, 0), a3, VOA0(lda2), VOA1(lda2));
            G8_WAIT_V(8); G8_WAIT_L(0); G8_BAR; G8_MMA(1, 0, At, B0); G8_MMA(1, 1, At, B1); G8_BAR; G8_SCHED;
        }
        if (wr == 0) G8_BAR;
        { Unit uc; get_unit(P, ph, bid + ui * G, uc); int efr = fr, efq = fq; asm volatile("" : "+v"(efr), "+v"(efq)); epilogue(P, uc, acc, wr, wc, efr, efq); }
        if (!has_next) break;
#pragma unroll
        for (int a = 0; a < 2; ++a)
#pragma unroll
            for (int b = 0; b < 2; ++b)
#pragma unroll
                for (int m = 0; m < 4; ++m)
#pragma unroll
                    for (int n = 0; n < 2; ++n) acc[a][b][m][n] = (f32x4){0.f, 0.f, 0.f, 0.f};
        cA = nA; cB = nB; clda = nlda; cldb = nldb; nt = nnt; ++ui;
        if (wr == 1) G8_BAR;
    }
    G8_WAIT_V(0);
    G8_BAR;
}
}

DI void tr_item(const float* W, int N, bf16_t* WT, int ldo, LAS float* scr, int kb, int nb, int lane) {
    const int k0 = 64 * kb, n0 = 32 * nb;
#pragma unroll 8
    for (int i = 0; i < 32; ++i) { const int kk = 2 * i + (lane >> 5); scr[kk * 33 + (lane & 31)] = __builtin_nontemporal_load(&W[(size_t)(k0 + kk) * N + n0 + (lane & 31)]); }
    LDS_WAIT();
    const int c = lane & 7;
#pragma unroll
    for (int j = 0; j < 4; ++j) { const int n = (lane >> 3) + 8 * j; const LAS float* s = scr + (8 * c) * 33 + n;
        u32x4 o; o.x = pk2(s[0 * 33], s[1 * 33]); o.y = pk2(s[2 * 33], s[3 * 33]); o.z = pk2(s[4 * 33], s[5 * 33]); o.w = pk2(s[6 * 33], s[7 * 33]);
        *(u32x4*)(WT + (size_t)(n0 + n) * ldo + k0 + 8 * c) = o; }
    LDS_WAIT();
}
DI void tr_matrix_item(const float* W, int K, int N, bf16_t* WT, int ldo, LAS float* scr, int item, int lane) {
    const int nblk = N / 32; tr_item(W, N, WT, ldo, scr, item / nblk, item % nblk, lane);
}

DI void p0_phase(LAS unsigned char* lds, const Params& P, const int tid, const int rep) {
    const int lane = tid & 63, wave = __builtin_amdgcn_readfirstlane(tid >> 6);
    const int gw = blockIdx.x * NWAVES + wave, NGW = gridDim.x * NWAVES;
    unsigned char* ws = P.ws;
    for (int pos = gw; pos < 1280; pos += NGW) {
        const int L = pos < 256 ? 256 : 1024; const int pp = pos < 256 ? pos : pos - 256;
        const float tt = (float)pp / (float)L;
        float feat = 0.f;
        if (lane == 0) feat = tt;
        else if (lane <= 32) { const int bi = (lane - 1) & 15; const float band = 1e-4f + (float)bi * ((15.0f - 1e-4f) / 15.0f); const float rev = tt * band;
            feat = (lane <= 16) ? cos_rev(rev) : -sin_rev(rev); }
        const float* w1 = P.in[I_FW1]; const float* w2 = P.in[I_FW2]; const float* w3 = P.in[I_FW3]; const float* fq = P.in[I_FFREQ];
        float a = P.in[I_FB1][lane];
#pragma unroll 3
        for (int e = 0; e < 33; ++e) { const float f = __builtin_bit_cast(float, __builtin_amdgcn_readlane(__builtin_bit_cast(int, feat), e)); a += f * w1[e * 64 + lane]; }
        float h1 = sin_rad(fq[lane] * a);
        a = P.in[I_FB2][lane];
#pragma unroll 8
        for (int e = 0; e < 64; ++e) { const float f = __builtin_bit_cast(float, __builtin_amdgcn_readlane(__builtin_bit_cast(int, h1), e)); a += f * w2[e * 64 + lane]; }
        float h2 = sin_rad(fq[64 + lane] * a);
        a = P.in[I_FB3][lane];
#pragma unroll 8
        for (int e = 0; e < 64; ++e) { const float f = __builtin_bit_cast(float, __builtin_amdgcn_readlane(__builtin_bit_cast(int, h2), e)); a += f * w3[e * 64 + lane]; }
        const float h3 = sin_rad(fq[128 + lane] * a);
        ((float*)(ws + OFF_H3))[pos * 64 + lane] = h3;
    }
    for (int item = gw; item < (rep ? 0 : 1536); item += NGW) {
        const int layer = item / 768, rem = item % 768, nchunk = rem >> 4, kc = rem & 15, n0 = nchunk * 256, k0 = kc * 128;
        const float* W = P.in[I_WADA] + (size_t)layer * 2048 * 12288;
        f32x4 acc[5];
#pragma unroll
        for (int j = 0; j < 5; ++j) acc[j] = (f32x4){0.f, 0.f, 0.f, 0.f};
#pragma unroll 1
        for (int half = 0; half < 2; ++half) {
            const int kb = k0 + half * 64;
            float av[5];
            av[0] = silu_f(P.in[I_CCTX][kb + lane]);
#pragma unroll
            for (int j = 1; j < 5; ++j) av[j] = silu_f(P.in[I_C][(j - 1) * 2048 + kb + lane]);
#pragma unroll 16
            for (int kk = 0; kk < 64; ++kk) {
                const f32x4 w = __builtin_nontemporal_load((const f32x4*)(W + (size_t)(kb + kk) * 12288 + n0 + 4 * lane));
#pragma unroll
                for (int j = 0; j < 5; ++j) { const float s = __builtin_bit_cast(float, __builtin_amdgcn_readlane(__builtin_bit_cast(int, av[j]), kk)); acc[j] = acc[j] + w * s; }
            }
        }
        float* mod = (float*)(ws + OFF_MOD);
#pragma unroll
        for (int j = 0; j < 5; ++j) {
            if (kc == 0) acc[j] = acc[j] + *(const f32x4*)(P.in[I_BADA] + layer * 12288 + n0 + 4 * lane);
            float* o = mod + (size_t)(layer * 5 + j) * 12288 + n0 + 4 * lane;
            atomicAdd(o + 0, acc[j][0]); atomicAdd(o + 1, acc[j][1]); atomicAdd(o + 2, acc[j][2]); atomicAdd(o + 3, acc[j][3]);
        }
    }
    LAS float* scr = (LAS float*)(lds + wave * 16384);
    constexpr int I_A = 32 * 192, I_B = 32 * 64, I_C2 = 32 * 384, I_D = 64 * 64, I_E = 32 * 256, I_F = 128 * 64, I_S = 64 * 64;
    constexpr int NITEMS = I_A + I_B + I_C2 + I_D + 2 * I_E + 2 * I_F + I_S;
    const bool bal = (NGW == 2048); constexpr int PART_A = 1536 * 27;
    const int it0 = !bal ? gw : (gw < 1536 ? gw : PART_A + (gw - 1536)), its = !bal ? NGW : (gw < 1536 ? 1536 : 512), ite = (!bal || gw >= 1536) ? NITEMS : PART_A;
    for (int it = it0; it < ite; it += its) {
        int r = NITEMS - 1 - it;
        if (r < I_A) { tr_matrix_item(P.in[I_HYWIN], 2048, 6144, (bf16_t*)(ws + OFF_WIN), 2048, scr, r, lane); continue; } r -= I_A;
        if (r < I_B) { tr_matrix_item(P.in[I_HYWOUT], 2048, 2048, (bf16_t*)(ws + OFF_WHYO), 2048, scr, r, lane); continue; } r -= I_B;
        if (r < I_C2) { tr_matrix_item(P.in[I_WQKVG], 2048, 12288, (bf16_t*)(ws + OFF_WQKVG), 2048, scr, r, lane); continue; } r -= I_C2;
        if (r < I_D) { tr_matrix_item(P.in[I_WO], 4096, 2048, (bf16_t*)(ws + OFF_WO), 4096, scr, r, lane); continue; } r -= I_D;
        if (r < 2 * I_E) { const int l = r / I_E; tr_matrix_item(P.in[I_MW1] + (size_t)l * 2048 * 8192, 2048, 8192, (bf16_t*)(ws + OFF_W1) + (size_t)l * 8192 * 2048, 2048, scr, r % I_E, lane); continue; } r -= 2 * I_E;
        if (r < 2 * I_F) { const int l = r / I_F; tr_matrix_item(P.in[I_MW2] + (size_t)l * 8192 * 2048, 8192, 2048, (bf16_t*)(ws + OFF_W2) + (size_t)l * 2048 * 8192, 8192, scr, r % I_F, lane); continue; } r -= 2 * I_F;
        { const int mi = r >> 6, sub = r & 63; const int b = mi >> 4, dir = (mi >> 3) & 1, h = mi & 7;
          tr_matrix_item(P.in[I_STATE] + (size_t)mi * 256 * 512, 256, 512, (bf16_t*)(ws + OFF_S0T) + (size_t)(b * 8 + h) * 512 * 512 + dir * 256, 512, scr, sub, lane); }
    }
}

DI void norm_rows(const Params& P, int mode, const int tid, const int row0, const int rowend, const int gw, const int NGW) {
    const int lane = tid & 63;
    const float* mod = (const float*)(P.ws + OFF_MOD);
    const int layer = (mode >= 2 && mode < 4) ? 1 : 0, which = mode & 1;
    const float* gvec = (mode == 4) ? P.in[I_FINALG] : P.in[I_NORMG] + (layer * 2 + which) * 2048;
    for (int row = row0 + gw; row < rowend; row += NGW) {
        f32x4 v[8]; float ss = 0.f;
        if (mode == 0) {
            const float* src = row < NPT ? P.in[I_XP] + (size_t)row * 2048 : P.in[I_XS] + (size_t)(row - NPT) * 2048;
            const f32x4* xr = (const f32x4*)src + lane;
#pragma unroll
            for (int j = 0; j < 8; ++j) v[j] = xr[64 * j];
        } else {
            const u32x2* xr = (const u32x2*)((const bf16_t*)(P.ws + OFF_X) + (size_t)row * 2048) + lane;
#pragma unroll
            for (int j = 0; j < 8; ++j) { const u32x2 w = xr[64 * j]; v[j] = (f32x4){bflo(w.x), bfhi(w.x), bflo(w.y), bfhi(w.y)}; }
        }
#pragma unroll
        for (int j = 0; j < 8; ++j) ss += (v[j][0] * v[j][0] + v[j][1] * v[j][1]) + (v[j][2] * v[j][2] + v[j][3] * v[j][3]);
        const float rstd = 1.0f / sqrtf(wave_sum(ss) * (1.0f / 2048.0f) + EPS);
        f32x4 gq[8];
#pragma unroll
        for (int j = 0; j < 8; ++j) gq[j] = *((const f32x4*)gvec + lane + 64 * j);
        if (mode == 4) {
            f32x4* o = (f32x4*)(P.out + (size_t)row * 2048) + lane;
#pragma unroll
            for (int j = 0; j < 8; ++j) __builtin_nontemporal_store(v[j] * rstd * gq[j], o + 64 * j);
        } else {
            const int cond = row < NPT ? 0 : 1 + ((row - NPT) >> 10);
            const float* sh = mod + (size_t)layer * 61440 + (size_t)cond * 12288 + (which ? 6144 : 0); const float* sc = sh + 2048;
            u32x2* o = (u32x2*)((bf16_t*)(P.ws + OFF_H) + (size_t)row * 2048) + lane;
            f32x4 s1q[8], s0q[8];
#pragma unroll
            for (int j = 0; j < 8; ++j) { s1q[j] = *((const f32x4*)sc + lane + 64 * j); s0q[j] = *((const f32x4*)sh + lane + 64 * j); }
#pragma unroll
            for (int j = 0; j < 8; ++j) { const f32x4 y = v[j] * rstd * gq[j] * (s1q[j] + 1.0f) + s0q[j]; u32x2 w; w.x = cvt_pk(y[0], y[1]); w.y = cvt_pk(y[2], y[3]); o[64 * j] = w; }
        }
    }
}

DI void norm_phase(const Params& P, int mode, const int tid) { norm_rows(P, mode, tid, 0, NTOK, blockIdx.x * NWAVES + (tid >> 6), gridDim.x * NWAVES); }
DI void panel_norm(const Params& P, int mode, const int tid) {
    const int lane = tid & 63, wave = tid >> 6;
    int pm, pn; g8::remap(32, 8, blockIdx.x, pm, pn);
    const int layer = (mode >= 2) ? 1 : 0, which = mode & 1;
    const int r0 = pm * 256 + pn * 32; const int cond = r0 < NPT ? 0 : 1 + ((r0 - NPT) >> 10);
    const float* gvec = P.in[I_NORMG] + (layer * 2 + which) * 2048;
    const float* sh = (const float*)(P.ws + OFF_MOD) + (size_t)layer * 61440 + (size_t)cond * 12288 + (which ? 6144 : 0); const float* sc = sh + 2048;
    f32x4 wq[8], sq[8];
#pragma unroll
    for (int j = 0; j < 8; ++j) { const f32x4 g = *((const f32x4*)gvec + lane + 64 * j), s1 = *((const f32x4*)sc + lane + 64 * j); sq[j] = *((const f32x4*)sh + lane + 64 * j); wq[j] = g * (s1 + 1.0f); }
    unsigned* cnt = (unsigned*)(P.ws + OFF_PCNT) + ((mode - 1) * 32 + pm) * 64;
    if (tid == 0) {
        __builtin_amdgcn_fence(__ATOMIC_RELEASE, "agent");
        asm volatile("s_waitcnt vmcnt(0)" ::: "memory");
        (void)__hip_atomic_fetch_add(cnt, 1u, __ATOMIC_RELAXED, __HIP_MEMORY_SCOPE_AGENT);
        unsigned sp = 0;
        while (__hip_atomic_load(cnt, __ATOMIC_RELAXED, __HIP_MEMORY_SCOPE_AGENT) < 8u) { __builtin_amdgcn_s_sleep(1); if (++sp > (1u << 20)) break; }
        __builtin_amdgcn_fence(__ATOMIC_ACQUIRE, "agent");
        asm volatile("s_waitcnt vmcnt(0)" ::: "memory");
    }
    __syncthreads();
    const int rw = r0 + wave * 4;
    u32x2 xq[4][8];
#pragma unroll
    for (int i = 0; i < 4; ++i) { const u32x2* xr = (const u32x2*)((const bf16_t*)(P.ws + OFF_X) + (size_t)(rw + i) * 2048) + lane;
#pragma unroll
        for (int j = 0; j < 8; ++j) xq[i][j] = xr[64 * j]; }
    float rs[4];
#pragma unroll
    for (int i = 0; i < 4; ++i) { float ss = 0.f;
#pragma unroll
        for (int j = 0; j < 8; ++j) { const float a = bflo(xq[i][j].x), b = bfhi(xq[i][j].x), c = bflo(xq[i][j].y), d = bfhi(xq[i][j].y); ss += (a * a + b * b) + (c * c + d * d); }
        rs[i] = 1.0f / sqrtf(wave_sum(ss) * (1.0f / 2048.0f) + EPS); }
#pragma unroll
    for (int i = 0; i < 4; ++i) { u32x2* o = (u32x2*)((bf16_t*)(P.ws + OFF_H) + (size_t)(rw + i) * 2048) + lane;
#pragma unroll
        for (int j = 0; j < 8; ++j) { const f32x4 x = (f32x4){bflo(xq[i][j].x), bfhi(xq[i][j].x), bflo(xq[i][j].y), bfhi(xq[i][j].y)};
            const f32x4 y = x * rs[i] * wq[j] + sq[j]; u32x2 w; w.x = cvt_pk(y[0], y[1]); w.y = cvt_pk(y[2], y[3]); o[64 * j] = w; } }
}

DI void filter_phase(LAS unsigned char* lds, const Params& P, const int tid) {
    const int lane = tid & 63, wave = __builtin_amdgcn_readfirstlane(tid >> 6);
    const int gw = blockIdx.x * NWAVES + wave, NGW = gridDim.x * NWAVES;
    const float MIND = -3.0701134573253945f, MAXD = -15.350567286626973f;
    const float* wout = P.in[I_FWOUT];
    LAS float* tile = (LAS float*)(lds + wave * 16896);
    for (int item = gw; item < 10240; item += NGW) {
        const int g = item >= 2048 ? 1 : 0; const int local = g ? item - 2048 : item;
        const int tile_i = local >> 9, chunk = local & 511; const int L = g ? 1024 : 256; const int pos = tile_i * 64 + lane;
        const int col0 = __builtin_amdgcn_readfirstlane(chunk * 16), od = col0 >> 11, c0 = col0 & 2047, o = od >> 1, dir = od & 1;
        const float* hp = (const float*)(P.ws + OFF_H3) + (size_t)((g ? 256 : 0) + tile_i * 64) * 64;
#pragma unroll 8
        for (int i = 0; i < 64; ++i) tile[i * 65 + lane] = hp[i * 64 + lane];
        LDS_WAIT();
        float acc[16];
#pragma unroll
        for (int k = 0; k < 16; ++k) acc[k] = 0.f;
#pragma unroll 4
        for (int i = 0; i < 64; ++i) {
            const float h = tile[lane * 65 + i];
            const float* wr_ = wout + (size_t)i * 8192 + col0;
#pragma unroll
            for (int k = 0; k < 16; ++k) acc[k] += h * wr_[k];
        }
        LDS_WAIT();
        const float tt = (float)pos / (float)L;
        bf16_t* R = (bf16_t*)(P.ws + (g ? OFF_RGS : OFF_RGP));
        const int x = dir == 0 ? (L - 1 - pos) : (pos == 0 ? 2 * L - 1 : L - 1 + pos);
#pragma unroll
        for (int k = 0; k < 16; ++k) {
            const int c = c0 + k; const float delta = fabsf(MIND + (float)c * ((MAXD - MIND) / 2047.0f));
            float val = acc[k] * __expf(-tt * delta);
            if (dir == 0) { if (pos == 0) val += P.in[I_FSKIP][o * 2048 + c]; } else { if (pos == 0) val = 0.f; }
            R[((size_t)(o * 2048 + c)) * (2 * L) + x] = (bf16_t)f2bf(val);
        }
    }
}

DI void conv_core(LAS unsigned char* Fb, LAS unsigned char* Ub, int g, int j, int lane, f32x16& acc) {
    const int L = g ? 1024 : 256, nblk = L >> 5, FS = 2 * L + 16, US = L + 8;
    const int n = lane & 31, hh = lane >> 5; const int ng = 32 * j + n;
    const int a = g ? (ng >> 2) : (ng >> 4), bt = g ? (ng & 3) : (ng & 15);
    const int a_lo = g ? 8 * j : 2 * j, a_hi = g ? 8 * j + 7 : 2 * j + 1;
#pragma unroll
    for (int e = 0; e < 16; ++e) acc[e] = 0.f;
    for (int d = a_lo - (nblk - 1); d <= a_hi; ++d) {
        const int ap = a - d; const bool valid = (ap >= 0) && (ap < nblk); const int apc = valid ? ap : 0;
#pragma unroll
        for (int ks = 0; ks < 2; ++ks) {
            const int x0 = (L - 1) - (32 * d + n - 16 * ks - 8 * hh);
            const int q = x0 & 7, y = x0 - q;
            const u32x4 av = *(const LAS u32x4*)(Fb + (size_t)((q * FS + y) * 2));
            u32x4 bv = *(const LAS u32x4*)(Ub + (size_t)((bt * US + 32 * apc + 16 * ks + 8 * hh) * 2));
            if (!valid) bv = (u32x4){0u, 0u, 0u, 0u};
            acc = __builtin_amdgcn_mfma_f32_32x32x16_bf16(__builtin_bit_cast(bf16x8, av), __builtin_bit_cast(bf16x8, bv), acc, 0, 0, 0);
        }
    }
}

struct CReg { u32x4 pv[6]; unsigned lr[6]; u32x4 fa[2]; u32x4 fb[2]; };
DI void conv_load(const Params& P, int it, int ch, int tl, CReg& R) {
    const int g = (it >> 8) & 1; const int cpair = (it & 255) | ((it >> 9) << 8); const int c = 2 * cpair + ch;
    const int L = g ? 1024 : 256; const int tokbase = g * 4096;
    const bf16_t* projT = (const bf16_t*)(P.ws + OFF_PROJT);
#pragma unroll
    for (int sec = 0; sec < 3; ++sec) {
        const bf16_t* row = projT + (size_t)(sec * 2048 + c) * 8192 + tokbase;
#pragma unroll
        for (int rep = 0; rep < 2; ++rep) {
            const int tok0 = (tl + rep * 256) * 8; const int t0 = tok0 & (L - 1);
            R.pv[sec * 2 + rep] = __builtin_nontemporal_load((const u32x4*)(row + tok0));
            const unsigned left = (t0 == 0) ? 0u : (unsigned)row[tok0 - 1];
            const unsigned right = (t0 + 8 == L) ? 0u : (unsigned)row[tok0 + 8];
            R.lr[sec * 2 + rep] = left | (right << 16);
        }
    }
#pragma unroll
    for (int o = 0; o < 2; ++o) {
        const bf16_t* Rg = (const bf16_t*)(P.ws + (g ? OFF_RGS : OFF_RGP)) + (size_t)(o * 2048 + c) * (2 * L);
        u32x4 a = (u32x4){0u, 0u, 0u, 0u}, b = (u32x4){0u, 0u, 0u, 0u};
        if (8 * tl < 2 * L) { a = *(const u32x4*)(Rg + 8 * tl); if (8 * tl + 8 < 2 * L) b = *(const u32x4*)(Rg + 8 * tl + 8); }
        R.fa[o] = a; R.fb[o] = b;
    }
}
DI void conv_store(const Params& P, int it, int ch, int tl, const CReg& R, LAS unsigned char* Uv, LAS unsigned char* X1, LAS unsigned char* X2) {
    const int g = (it >> 8) & 1; const int cpair = (it & 255) | ((it >> 9) << 8); const int c = 2 * cpair + ch;
    const int L = g ? 1024 : 256, lgL = g ? 10 : 8, US = L + 8;
#pragma unroll
    for (int sec = 0; sec < 3; ++sec) {
        const int cc = sec * 2048 + c;
        const float w0 = P.in[I_HYCW][cc], w1 = P.in[I_HYCW][6144 + cc], w2 = P.in[I_HYCW][12288 + cc], bb = P.in[I_HYCB][cc];
        LAS unsigned char* dst = sec == 0 ? Uv : (sec == 1 ? X1 : X2);
#pragma unroll
        for (int rep = 0; rep < 2; ++rep) {
            const int tok0 = (tl + rep * 256) * 8; const int t0 = tok0 & (L - 1), bt = tok0 >> lgL;
            const u32x4 pv = R.pv[sec * 2 + rep]; const unsigned lr = R.lr[sec * 2 + rep];
            float f[10]; f[0] = bflo(lr); f[1] = bflo(pv.x); f[2] = bfhi(pv.x); f[3] = bflo(pv.y); f[4] = bfhi(pv.y); f[5] = bflo(pv.z); f[6] = bfhi(pv.z); f[7] = bflo(pv.w); f[8] = bfhi(pv.w); f[9] = bfhi(lr);
            float o8[8];
#pragma unroll
            for (int e = 0; e < 8; ++e) o8[e] = w0 * f[e] + w1 * f[e + 1] + w2 * f[e + 2] + bb;
            u32x4 w; w.x = cvt_pk(o8[0], o8[1]); w.y = cvt_pk(o8[2], o8[3]); w.z = cvt_pk(o8[4], o8[5]); w.w = cvt_pk(o8[6], o8[7]);
            *(LAS u32x4*)(dst + (size_t)((bt * US + t0) * 2)) = w;
        }
    }
}
DI void conv_store_filter(int L, int tl, const u32x4 fa, const u32x4 fb, LAS unsigned char* Fb) {
    const int FS = 2 * L + 16;
    if (8 * tl < 2 * L) {
        const unsigned Dw[8] = {fa.x, fa.y, fa.z, fa.w, fb.x, fb.y, fb.z, fb.w};
#pragma unroll
        for (int m = 0; m < 4; ++m) {
            u32x4 we = (u32x4){Dw[m], Dw[m + 1], Dw[m + 2], Dw[m + 3]};
            u32x4 wo; wo.x = __builtin_amdgcn_alignbit(Dw[m + 1], Dw[m], 16); wo.y = __builtin_amdgcn_alignbit(Dw[m + 2], Dw[m + 1], 16);
            wo.z = __builtin_amdgcn_alignbit(Dw[m + 3], Dw[m + 2], 16); wo.w = __builtin_amdgcn_alignbit(Dw[m + 4], Dw[m + 3], 16);
            *(LAS u32x4*)(Fb + (size_t)(((2 * m) * FS + 8 * tl) * 2)) = we;
            *(LAS u32x4*)(Fb + (size_t)(((2 * m + 1) * FS + 8 * tl) * 2)) = wo;
        }
    }
}

DI void conv_phase(LAS unsigned char* lds, const Params& P, const int tid) {
    const int wid = __builtin_amdgcn_readfirstlane(tid >> 6), lane = tid & 63, ch = wid >> 2, j = wid & 3, tl = tid & 255;
    constexpr int CH_BYTES = 68608, F_BYTES = 33280, A_BYTES = 8704;
    LAS unsigned char* base = lds + ch * CH_BYTES;
    LAS unsigned char* Fb = base; LAS unsigned char* Uv = base + F_BYTES; LAS unsigned char* X1 = Uv + A_BYTES; LAS unsigned char* X2 = X1 + A_BYTES; LAS unsigned char* Zb = X2 + A_BYTES;
    bf16_t* z2T = (bf16_t*)(P.ws + OFF_Z2T);
    const int G = gridDim.x;
    CReg R;
    if ((int)blockIdx.x < 2048) conv_load(P, blockIdx.x, ch, tl, R);
    for (int it = blockIdx.x; it < 2048; it += G) {
        const int g = (it >> 8) & 1; const int cpair = (it & 255) | ((it >> 9) << 8); const int c = 2 * cpair + ch;
        const int L = g ? 1024 : 256, US = L + 8; const int tokbase = g * 4096;
        conv_store(P, it, ch, tl, R, Uv, X1, X2);
        conv_store_filter(L, tl, R.fa[0], R.fb[0], Fb);
        __syncthreads();
        const int n = lane & 31, hh = lane >> 5; const int ng = 32 * j + n;
        const int a = g ? (ng >> 2) : (ng >> 4), bt = g ? (ng & 3) : (ng & 15);
        f32x16 acc;
        conv_core(Fb, Uv, g, j, lane, acc);
#pragma unroll
        for (int rg = 0; rg < 4; ++rg) {
            const int t0 = 32 * a + 8 * rg + 4 * hh; const int idx = bt * US + t0;
            const u32x2 xv = *(const LAS u32x2*)(X1 + (size_t)(idx * 2));
            u32x2 w; w.x = cvt_pk(bflo(xv.x) * acc[4 * rg + 0], bfhi(xv.x) * acc[4 * rg + 1]); w.y = cvt_pk(bflo(xv.y) * acc[4 * rg + 2], bfhi(xv.y) * acc[4 * rg + 3]);
            *(LAS u32x2*)(Zb + (size_t)(idx * 2)) = w;
        }
        __syncthreads();
        conv_store_filter(L, tl, R.fa[1], R.fb[1], Fb);
        __syncthreads();
        if (it + G < 2048) conv_load(P, it + G, ch, tl, R);
        conv_core(Fb, Zb, g, j, lane, acc);
#pragma unroll
        for (int rg = 0; rg < 4; ++rg) {
            const int t0 = 32 * a + 8 * rg + 4 * hh; const int idx = bt * US + t0;
            const u32x2 xv = *(const LAS u32x2*)(X2 + (size_t)(idx * 2));
            u32x2 w; w.x = cvt_pk(bflo(xv.x) * acc[4 * rg + 0], bfhi(xv.x) * acc[4 * rg + 1]); w.y = cvt_pk(bflo(xv.y) * acc[4 * rg + 2], bfhi(xv.y) * acc[4 * rg + 3]);
            *(u32x2*)(z2T + (size_t)c * 8192 + tokbase + bt * L + t0) = w;
        }
        __syncthreads();
    }
}

DI void transpose_phase(LAS unsigned char* lds, const Params& P, const int tid) {
    const int lane = tid & 63, wave = __builtin_amdgcn_readfirstlane(tid >> 6);
    const int gw = blockIdx.x * NWAVES + wave, NGW = gridDim.x * NWAVES;
    LAS bf16_t* tile = (LAS bf16_t*)(lds + wave * 16384);
    const bf16_t* src = (const bf16_t*)(P.ws + OFF_Z2T); bf16_t* dst = (bf16_t*)(P.ws + OFF_Z2);
    for (int item = gw; item < 4096; item += NGW) {
        const int tokt = item >> 5, ct = item & 31; const int tok0 = tokt * 64, c0 = ct * 64;
#pragma unroll
        for (int rr = 0; rr < 16; ++rr) { const int row = rr * 4 + (lane >> 4), cc = lane & 15;
            const u32x2 v = __builtin_nontemporal_load((const u32x2*)(src + (size_t)(c0 + row) * 8192 + tok0 + 4 * cc));
            *(LAS u32x2*)(tile + row * 68 + 4 * cc) = v; }
        LDS_WAIT();
#pragma unroll
        for (int cch = 0; cch < 8; ++cch) {
            unsigned h[8];
#pragma unroll
            for (int e = 0; e < 8; ++e) h[e] = tile[(8 * cch + e) * 68 + lane];
            u32x4 w; w.x = h[0] | (h[1] << 16); w.y = h[2] | (h[3] << 16); w.z = h[4] | (h[5] << 16); w.w = h[6] | (h[7] << 16);
            *(u32x4*)(dst + (size_t)(tok0 + lane) * 2048 + c0 + 8 * cch) = w;
        }
        LDS_WAIT();
    }
}

DI void gate_phase(const Params& P, const int tid) {
    const int lane = tid & 63, wave = tid >> 6;
    const int gw = blockIdx.x * NWAVES + wave, NGW = gridDim.x * NWAVES;
    const bf16_t* Y = (const bf16_t*)(P.ws + OFF_Y); const bf16_t* G = (const bf16_t*)(P.ws + OFF_G); bf16_t* A2 = (bf16_t*)(P.ws + OFF_A2);
    for (int row = gw; row < NTOK; row += NGW) {
        u32x4 yq[8], gq[8];
#pragma unroll
        for (int h = 0; h < 8; ++h) { const size_t off = (size_t)row * 4096 + h * 512 + lane * 8; yq[h] = __builtin_nontemporal_load((const u32x4*)(Y + off)); gq[h] = __builtin_nontemporal_load((const u32x4*)(G + off)); }
#pragma unroll
        for (int h = 0; h < 8; ++h) {
            const size_t off = (size_t)row * 4096 + h * 512 + lane * 8;
            const u32x4 yv = yq[h], gv = gq[h];
            float y[8] = {bflo(yv.x), bfhi(yv.x), bflo(yv.y), bfhi(yv.y), bflo(yv.z), bfhi(yv.z), bflo(yv.w), bfhi(yv.w)};
            float gg[8] = {bflo(gv.x), bfhi(gv.x), bflo(gv.y), bfhi(gv.y), bflo(gv.z), bfhi(gv.z), bflo(gv.w), bfhi(gv.w)};
            float s = 0.f;
#pragma unroll
            for (int e = 0; e < 8; ++e) s += y[e];
            const float mu = wave_sum(s) * (1.0f / 512.0f);
            float q = 0.f;
#pragma unroll
            for (int e = 0; e < 8; ++e) { y[e] -= mu; q += y[e] * y[e]; }
            const float rstd = 1.0f / sqrtf(wave_sum(q) * (1.0f / 512.0f) + EPS);
            const f32x4* gn = (const f32x4*)(P.in[I_GNG] + h * 512 + lane * 8); const f32x4 n0 = gn[0], n1 = gn[1];
            float o[8];
#pragma unroll
            for (int e = 0; e < 8; ++e) o[e] = gg[e] * y[e] * rstd * (e < 4 ? n0[e & 3] : n1[e & 3]);
            u32x4 w; w.x = cvt_pk(o[0], o[1]); w.y = cvt_pk(o[2], o[3]); w.z = cvt_pk(o[4], o[5]); w.w = cvt_pk(o[6], o[7]);
            *(u32x4*)(A2 + off) = w;
        }
    }
}

__global__ void __launch_bounds__(512, 2) mega_fwd(Params P) {
    extern __shared__ __attribute__((aligned(16))) unsigned char lds_raw[];
    LAS unsigned char* lds = (LAS unsigned char*)lds_raw;
    cg::grid_group grid = cg::this_grid();
    const int wv0 = __builtin_amdgcn_readfirstlane(threadIdx.x >> 6);
    volatile LAS unsigned* st = (volatile LAS unsigned*)(lds + LDS_BYTES - 16);
    if (threadIdx.x < 4) st[threadIdx.x] = 0u;
    __syncthreads();
    const XcdBarrier xbar = xcd_barrier_post((unsigned*)(P.ws + OFF_BAR), st);
    const bool fusedn = (gridDim.x == 256);
    for (int ph = P.ph_lo; ph < P.ph_hi; ++ph) {
        if (fusedn && (ph == g8::PH_N1 || ph == g8::PH_N2 || ph == g8::PH_N3)) continue;
        if (ph > P.ph_lo) { if (ph == P.ph_lo + 1) grid.sync(); else xcd_barrier(xbar); for (int i = 0; i < P.extrasync; ++i) xcd_barrier(xbar); }
        const int nrep = ((P.dupmask >> ph) & 1) ? 2 : 1;
        for (int rep = 0; rep < nrep; ++rep) {
        if (rep) xcd_barrier(xbar);
        int tid = wv0 * 64 + (int)__builtin_amdgcn_mbcnt_hi(~0u, __builtin_amdgcn_mbcnt_lo(~0u, 0u)); asm volatile("" : "+v"(tid));
        switch (ph) {
        case g8::PH_P0: p0_phase(lds, P, tid, rep); break;
        case g8::PH_P1: norm_phase(P, 0, tid); filter_phase(lds, P, tid); break;
        case g8::PH_CONV: conv_phase(lds, P, tid); break;
        case g8::PH_TR: transpose_phase(lds, P, tid); break;
        case g8::PH_N1: norm_phase(P, 1, tid); break;
        case g8::PH_N2: norm_phase(P, 2, tid); break;
        case g8::PH_N3: norm_phase(P, 3, tid); break;
        case g8::PH_FIN: norm_phase(P, 4, tid); break;
        case g8::PH_GATE: gate_phase(P, tid); break;
        default: g8::gemm_phase(lds, P, ph, tid, rep);
            if (fusedn && rep == 0) { if (ph == g8::PH_HYOUT) panel_norm(P, 1, tid); else if (ph == g8::PH_MLP2A) panel_norm(P, 2, tid); else if (ph == g8::PH_WO) panel_norm(P, 3, tid); }
            break;
        }
        }
    }
}

extern "C" void kernel_launch(void* const* d_in, const int* in_sizes, int n_in, void* d_out, int out_size, void* d_ws, size_t ws_size, hipStream_t stream) {
    static int grid_blocks = 0;
    if (grid_blocks == 0) {
        if (n_in != N_IN || ws_size < WS_NEED) { fprintf(stderr, "kernel_launch: unexpected inputs (n_in %d, ws %zu)\n", n_in, ws_size); grid_blocks = -1; return; }
        int dev = 0, cus = 0, per_cu = 0;
        hipGetDevice(&dev);
        hipDeviceGetAttribute(&cus, hipDeviceAttributeMultiprocessorCount, dev);
        if (hipFuncSetAttribute((const void*)mega_fwd, hipFuncAttributeMaxDynamicSharedMemorySize, LDS_BYTES) != hipSuccess) { fprintf(stderr, "kernel_launch: hipFuncSetAttribute failed\n"); grid_blocks = -1; return; }
        if (hipOccupancyMaxActiveBlocksPerMultiprocessor(&per_cu, (const void*)mega_fwd, NWAVES * 64, LDS_BYTES) != hipSuccess || per_cu < 1) { fprintf(stderr, "kernel_launch: occupancy query failed (%d)\n", per_cu); grid_blocks = -1; return; }
        grid_blocks = cus * per_cu;
    }
    if (grid_blocks < 0) return;
    (void)hipMemsetAsync((char*)d_ws + OFF_MOD, 0, CTL_ZERO_BYTES, stream);
    Params p{};
    for (int i = 0; i < 30; ++i) p.in[i] = (const float*)d_in[i];
    p.out = (float*)d_out; p.ws = (unsigned char*)d_ws; p.ph_lo = 0; p.ph_hi = g8::NPH; p.dupmask = DUPMASK; p.extrasync = EXTRASYNC;
    void* args[] = {&p};
    hipError_t e = hipLaunchCooperativeKernel((const void*)mega_fwd, dim3(grid_blocks), dim3(NWAVES * 64), args, LDS_BYTES, stream);
    if (e != hipSuccess) fprintf(stderr, "cooperative launch failed: %s (grid %d)\n", hipGetErrorString(e), grid_blocks);
}
```
